# Optimizing an MI355X kernel written in HIP

```python
import math
import jax, jax.numpy as jnp
from jax import lax
import numpy as np

D_MODEL = 1024
BATCH = 8
SEQ = 2048
DEPTH = 2
DEC_BATCH = 128
DEC_SEQ = 1
PAST_LEN = 16384
PAGE_SIZE = 128

MIX_W = D_MODEL
W_A = MIX_W // 2
W_B = MIX_W - W_A
H_A = 8
HD_A = W_A // H_A
H_B = 8
HD_B = W_B // H_B
CHUNK = 128
CONV_W = 4
C_RG = 8.0
D_FF = 2816
PLE_DIM = 256
IN_W = 2 * W_A + 2 * W_B
EPS = 1e-6

kernel_name = "hymba_gmlp_rglru_macaron_decoder_step"


def rms_norm(x, g):
    xf = x.astype(jnp.float32)
    y = xf * lax.rsqrt(jnp.mean(xf * xf, axis=-1, keepdims=True) + EPS)
    return (y * g.astype(jnp.float32)).astype(x.dtype)


def layer_norm(x, g, b):
    xf = x.astype(jnp.float32)
    mu = jnp.mean(xf, axis=-1, keepdims=True)
    xc = xf - mu
    y = xc * lax.rsqrt(jnp.mean(xc * xc, axis=-1, keepdims=True) + EPS)
    return (y * g.astype(jnp.float32) + b.astype(jnp.float32)).astype(x.dtype)


def swiglu(x, wg, wu, wd):
    return (jax.nn.silu(x @ wg) * (x @ wu)) @ wd


def chunk_spatial_gate(v, w_s, b_s):
    B, L, _ = v.shape
    n = -(-L // CHUNK)
    vp = jnp.pad(v, ((0, 0), (0, n * CHUNK - L), (0, 0)))
    vc = vp.reshape(B, n, CHUNK, H_A, HD_A)
    mask = jnp.tril(jnp.ones((CHUNK, CHUNK), dtype=bool))
    w = jnp.where(mask[None], w_s, jnp.zeros_like(w_s))
    s = jnp.einsum('hij,bnjhd->bnihd', w, vc) + b_s.T[None, None, :, :, None]
    return s.reshape(B, n * CHUNK, W_A)[:, :L]


def causal_conv(x, buf, w, b):
    L = x.shape[1]
    xp = jnp.concatenate([buf.astype(x.dtype), x], axis=1)
    y = b
    for k in range(CONV_W):
        y = y + xp[:, k:k + L] * w[k]
    return y, xp[:, -(CONV_W - 1):]


def block_diag(x, w, b):
    B, L, _ = x.shape
    xh = x.reshape(B, L, H_B, HD_B)
    return jnp.einsum('blhi,hij->blhj', xh, w).reshape(B, L, W_B) + b


def rg_lru(x, h0, w_r, b_r, w_i, b_i, lam):
    xf = x.astype(jnp.float32)
    r = jax.nn.sigmoid(block_diag(xf, w_r.astype(jnp.float32), b_r.astype(jnp.float32)))
    i = jax.nn.sigmoid(block_diag(xf, w_i.astype(jnp.float32), b_i.astype(jnp.float32)))
    log_a = -C_RG * r * jax.nn.softplus(-lam.astype(jnp.float32))
    a = jnp.exp(log_a)
    u = jnp.sqrt(jnp.maximum(-jnp.expm1(2.0 * log_a), 0.0)) * (i * xf)

    def step(h, inp):
        a_t, u_t = inp
        h = a_t * h + u_t
        return h, h

    hT, hs = lax.scan(step, h0.astype(jnp.float32), (jnp.swapaxes(a, 0, 1), jnp.swapaxes(u, 0, 1)))
    return jnp.swapaxes(hs, 0, 1).astype(x.dtype), hT.astype(h0.dtype)


def hybrid_mix(h, buf, h0, w_in, ln_v_g, ln_v_b, w_s, b_s, conv_w, conv_b,
               w_r, b_r, w_i, b_i, lam, w_out):
    z = h @ w_in
    u = jax.nn.gelu(z[..., :W_A])
    v = layer_norm(jax.nn.gelu(z[..., W_A:2 * W_A]), ln_v_g, ln_v_b)
    xr = z[..., 2 * W_A:2 * W_A + W_B]
    gt = z[..., 2 * W_A + W_B:]
    y_a = u * chunk_spatial_gate(v, w_s, b_s)
    xc, new_buf = causal_conv(xr, buf, conv_w, conv_b)
    yr, hT = rg_lru(xc, h0, w_r, b_r, w_i, b_i, lam)
    y_b = yr * jax.nn.gelu(gt)
    out = jnp.concatenate([y_a, y_b], axis=-1) @ w_out
    return out, v, new_buf, hT


def setup_inputs(seed: int = 0) -> dict:
    key = jax.random.key(seed)
    ks = iter(jax.random.split(key, 48))
    f32 = jnp.float32

    def nrm(shape, scale):
        return jax.random.normal(next(ks), shape, f32) * scale

    def gain(shape):
        return 1.0 + 0.05 * jax.random.normal(next(ks), shape, f32)

    x_prompt = nrm((BATCH, SEQ, D_MODEL), 1.0)
    x_sample = nrm((DEC_BATCH, DEC_SEQ, D_MODEL), 1.0)
    state_h = nrm((DEPTH, DEC_BATCH, W_B), 0.5)
    state_conv = nrm((DEPTH, DEC_BATCH, CONV_W - 1, W_B), 1.0)
    p_prompt = nrm((DEPTH, BATCH, SEQ, PLE_DIM), 1.0)
    p_sample = nrm((DEPTH, DEC_BATCH, DEC_SEQ, PLE_DIM), 1.0)

    u_a = jax.random.uniform(next(ks), (DEPTH, W_B), f32, minval=0.9, maxval=0.999)
    a0 = u_a ** (1.0 / C_RG)
    lam = jnp.log(a0) - jnp.log1p(-a0)

    return {
        "x_prompt": x_prompt, "x_sample": x_sample,
        "state_h": state_h, "state_conv": state_conv,
        "p_prompt": p_prompt, "p_sample": p_sample,
        "n_ffn1": gain((DEPTH, D_MODEL)),
        "w_ffn1_gate": nrm((DEPTH, D_MODEL, D_FF), D_MODEL ** -0.5),
        "w_ffn1_up": nrm((DEPTH, D_MODEL, D_FF), D_MODEL ** -0.5),
        "w_ffn1_down": nrm((DEPTH, D_FF, D_MODEL), D_FF ** -0.5),
        "n_mix": gain((DEPTH, D_MODEL)),
        "w_in": nrm((DEPTH, D_MODEL, IN_W), D_MODEL ** -0.5),
        "ln_v_g": gain((DEPTH, W_A)),
        "ln_v_b": nrm((DEPTH, W_A), 0.02),
        "w_s": nrm((DEPTH, H_A, CHUNK, CHUNK), CHUNK ** -0.5),
        "b_s": gain((DEPTH, H_A, CHUNK)),
        "conv_w": nrm((DEPTH, CONV_W, W_B), CONV_W ** -0.5),
        "conv_b": nrm((DEPTH, W_B), 0.02),
        "w_r": nrm((DEPTH, H_B, HD_B, HD_B), HD_B ** -0.5),
        "b_r": nrm((DEPTH, W_B), 0.02),
        "w_i": nrm((DEPTH, H_B, HD_B, HD_B), HD_B ** -0.5),
        "b_i": nrm((DEPTH, W_B), 0.02),
        "lam": lam,
        "w_out": nrm((DEPTH, MIX_W, D_MODEL), MIX_W ** -0.5),
        "n_ffn2": gain((DEPTH, D_MODEL)),
        "w_ffn2_gate": nrm((DEPTH, D_MODEL, D_FF), D_MODEL ** -0.5),
        "w_ffn2_up": nrm((DEPTH, D_MODEL, D_FF), D_MODEL ** -0.5),
        "w_ffn2_down": nrm((DEPTH, D_FF, D_MODEL), D_FF ** -0.5),
        "n_ple": gain((DEPTH, D_MODEL)),
        "w_ple_gate": nrm((DEPTH, D_MODEL, D_MODEL), D_MODEL ** -0.5),
        "w_ple_proj": nrm((DEPTH, PLE_DIM, D_MODEL), PLE_DIM ** -0.5),
        "n_final": gain((D_MODEL,)),
    }


def reference(x_prompt, x_sample, state_h, state_conv, p_prompt, p_sample,
              n_ffn1, w_ffn1_gate, w_ffn1_up, w_ffn1_down,
              n_mix, w_in, ln_v_g, ln_v_b, w_s, b_s, conv_w, conv_b,
              w_r, b_r, w_i, b_i, lam, w_out,
              n_ffn2, w_ffn2_gate, w_ffn2_up, w_ffn2_down,
              n_ple, w_ple_gate, w_ple_proj, n_final):
    B = x_prompt.shape[0]
    xp, xs = x_prompt, x_sample
    buf_p0 = jnp.zeros((B, CONV_W - 1, W_B), x_prompt.dtype)
    h_p0 = jnp.zeros((B, W_B), state_h.dtype)
    hp_out, cp_out, hs_out, cs_out, vs_out = [], [], [], [], []

    for i in range(DEPTH):
        def layer(x, p, buf, h0):
            x = x + 0.5 * swiglu(rms_norm(x, n_ffn1[i]), w_ffn1_gate[i], w_ffn1_up[i], w_ffn1_down[i])
            mix, v, new_buf, hT = hybrid_mix(
                rms_norm(x, n_mix[i]), buf, h0, w_in[i], ln_v_g[i], ln_v_b[i], w_s[i], b_s[i],
                conv_w[i], conv_b[i], w_r[i], b_r[i], w_i[i], b_i[i], lam[i], w_out[i])
            x = x + mix
            x = x + 0.5 * swiglu(rms_norm(x, n_ffn2[i]), w_ffn2_gate[i], w_ffn2_up[i], w_ffn2_down[i])
            gate = jax.nn.sigmoid(rms_norm(x, n_ple[i]) @ w_ple_gate[i])
            x = x + gate * (p @ w_ple_proj[i])
            return x, v, new_buf, hT

        xp, _, cbuf_p, hT_p = layer(xp, p_prompt[i], buf_p0, h_p0)
        xs, v_s, cbuf_s, hT_s = layer(xs, p_sample[i], state_conv[i], state_h[i])
        hp_out.append(hT_p)
        cp_out.append(cbuf_p)
        hs_out.append(hT_s)
        cs_out.append(cbuf_s)
        vs_out.append(v_s)

    y_prompt = rms_norm(xp, n_final)
    y_sample = rms_norm(xs, n_final)
    state_h_prompt = jnp.stack(hp_out)
    state_conv_prompt = jnp.stack(cp_out)
    state_h_sample = jnp.stack(hs_out)
    state_conv_sample = jnp.stack(cs_out)
    chunk_v_sample = jnp.stack(vs_out)
    return (y_prompt, y_sample, state_h_prompt, state_conv_prompt, state_h_sample, state_conv_sample, chunk_v_sample)
```

```cpp
#include <hip/hip_runtime.h>
#include <hip/hip_cooperative_groups.h>
#include <cstdio>
#include <cstdint>
namespace cg = cooperative_groups;

#ifndef ONE_LAUNCH
#define ONE_LAUNCH 1
#endif

namespace pg8 {
#define PG8_LAS __attribute__((address_space(3)))
typedef unsigned short bf16_t;
typedef short bf16x8 __attribute__((ext_vector_type(8)));
typedef float f32x4 __attribute__((ext_vector_type(4)));
typedef unsigned u32x4 __attribute__((ext_vector_type(4)));
typedef unsigned u32x2 __attribute__((ext_vector_type(2)));
constexpr int BM = 256, BK = 64, HALF = 128, HTB = HALF * BK * 2, STAGE_BYTES = 8 * HTB, NXCD = 8, WGM = 8;

__host__ __device__ __forceinline__ int lds_byte(int r, int c) { const int st = (r >> 4) * 2 + (c >> 5), rr = r & 15, cc = c & 31, ob = rr * 64 + cc * 2; return st * 1024 + (ob ^ (((ob >> 9) & 1) << 5)); }
__host__ __device__ __forceinline__ void stage_rc(int b, int& R, int& C) { const int st = b / 1024, sb = b % 1024, swz = sb ^ (((sb >> 9) & 1) << 5); R = (st >> 1) * 16 + swz / 64; C = (st & 1) * 32 + (swz % 64) / 2; }
__host__ __device__ __forceinline__ int perm32(int rho) { const int n = rho >> 4, i = rho & 15; return 8 * (i >> 2) + 4 * n + (i & 3); }

struct Unit { int pm, pn; };
struct Gemm { const bf16_t* A; const bf16_t* Bt; int M, N, K; };

struct StaticOrder {
    int nM, nN, nwg, G, c;
    __host__ __device__ void init(int M, int N, int G_, int c_) { nM = M / BM; nN = N / BM; nwg = nM * nN; G = G_; c = c_; }
    __host__ __device__ bool next(int i, Unit& u) const {
        const long L = (long)i * G + c; if (L >= nwg) return false;
        int wgid = (int)L; { const int q = nwg / NXCD, r = nwg % NXCD, xcd = wgid % NXCD, off = wgid / NXCD; wgid = (xcd < r ? xcd * (q + 1) : r * (q + 1) + (xcd - r) * q) + off; }
        const int nig = WGM * nN, gid = wgid / nig, fm = gid * WGM, gsz = (nM - fm) < WGM ? (nM - fm) : WGM;
        u.pm = fm + ((wgid % nig) % gsz); u.pn = (wgid % nig) / gsz; return true;
    }
    __device__ __forceinline__ void a_ready(const Unit&) const {}
    __device__ __forceinline__ void done(const Unit&) const {}
};

__device__ __forceinline__ unsigned cvt_pk_bf16(float lo, float hi) { unsigned r; asm("v_cvt_pk_bf16_f32 %0, %1, %2" : "=v"(r) : "v"(lo), "v"(hi)); return r; }

template <class Epi, class Sched, bool ALIGN_EPI = false, bool SP2 = false>
__device__ __forceinline__ void gemm_phase(PG8_LAS unsigned char* lds, const Gemm g, const Sched& S, const Epi& E, const int wid) {
    int lane_ = (int)__builtin_amdgcn_mbcnt_hi(~0u, __builtin_amdgcn_mbcnt_lo(~0u, 0u)); asm volatile("" : "+v"(lane_));
    const int lane = lane_, tid = wid * 64 + lane, wr = wid >> 2, wc = wid & 3, fr = lane & 15, fq = lane >> 4;
    const int K = g.K, nt = K / BK;
    unsigned voffA[2], voffB[2];
#pragma unroll
    for (int i = 0; i < 2; ++i) { int R, C; stage_rc(tid * 16 + i * 8192, R, C); const int Rb = Epi::PERM ? ((R & ~31) + perm32(R & 31)) : R;
        voffA[i] = (unsigned)(R * K + C) * 2u; voffB[i] = (unsigned)(Rb * K + C) * 2u; }
    const size_t kstep = (size_t)(BK * 2);
    const size_t hstep = (size_t)HALF * K * 2;
    const size_t tstep = 2 * hstep;
    const unsigned ldsw = (unsigned)wid * 1024u;
    const int aoff = lds_byte(wr * 64 + fr, fq * 8), boff = lds_byte(wc * 32 + fr, fq * 8);
#define PG8_SA(b, h) (((b) * 2 + (h)) * HTB)
#define PG8_SB(b, h) ((4 + (b) * 2 + (h)) * HTB)
#define PG8_STAGE(bufoff, gbase, voff) do { _Pragma("unroll") for (int _i = 0; _i < 2; ++_i) \
        __builtin_amdgcn_global_load_lds((const unsigned*)((const char*)(gbase) + (voff)[_i]), (PG8_LAS unsigned*)(lds + (bufoff) + ldsw + _i * 8192), 16, 0, 0); } while (0)
#define PG8_LDA(dst, b, h) do { _Pragma("unroll") for (int m = 0; m < 4; ++m) _Pragma("unroll") for (int k = 0; k < 2; ++k) dst[m][k] = *(const PG8_LAS bf16x8*)(lds + PG8_SA(b, h) + aoff + m * 2048 + k * 1024); } while (0)
#define PG8_LDB(dst, b, h) do { _Pragma("unroll") for (int n = 0; n < 2; ++n) _Pragma("unroll") for (int k = 0; k < 2; ++k) dst[n][k] = *(const PG8_LAS bf16x8*)(lds + PG8_SB(b, h) + boff + n * 2048 + k * 1024); } while (0)
#define PG8_MMA(ai, bj, At, Bt) do { __builtin_amdgcn_s_setprio(1); _Pragma("unroll") for (int m = 0; m < 4; ++m) _Pragma("unroll") for (int n = 0; n < 2; ++n) _Pragma("unroll") for (int k = 0; k < 2; ++k) \
        acc[ai][bj][m][n] = __builtin_amdgcn_mfma_f32_16x16x32_bf16(Bt[n][k], At[m][k], acc[ai][bj][m][n], 0, 0, 0); __builtin_amdgcn_s_setprio(0); } while (0)
#define PG8_WAIT_V(n) asm volatile("s_waitcnt vmcnt(" #n ")" ::: "memory")
#define PG8_WAIT_L(n) asm volatile("s_waitcnt lgkmcnt(" #n ")" ::: "memory")
#define PG8_BAR __builtin_amdgcn_s_barrier()
#define PG8_SCHED __builtin_amdgcn_sched_barrier(0)
    Unit cur, nxt; int ui = 0;
    if (!S.next(0, cur)) return;
    f32x4 acc[2][2][4][2];
#pragma unroll
    for (int a = 0; a < 2; ++a)
#pragma unroll
        for (int b = 0; b < 2; ++b)
#pragma unroll
            for (int m = 0; m < 4; ++m)
#pragma unroll
                for (int n = 0; n < 2; ++n) acc[a][b][m][n] = (f32x4){0.f, 0.f, 0.f, 0.f};
    bf16x8 At[4][2], B0[2][2], B1[2][2];
    const char* cA = (const char*)g.A + (size_t)cur.pm * tstep; const char* cB = (const char*)g.Bt + (size_t)cur.pn * tstep;
    S.a_ready(cur);
    if constexpr (SP2) {
        PG8_STAGE(PG8_SB(0, 0), cB, voffB); PG8_STAGE(PG8_SB(0, 1), cB + hstep, voffB); PG8_STAGE(PG8_SA(0, 0), cA, voffA); PG8_STAGE(PG8_SA(0, 1), cA + hstep, voffA);
        if (wr == 1) PG8_BAR;
        PG8_WAIT_V(2); PG8_BAR;
        PG8_STAGE(PG8_SB(1, 0), cB + kstep, voffB); PG8_STAGE(PG8_SA(1, 0), cA + kstep, voffA); PG8_STAGE(PG8_SB(1, 1), cB + hstep + kstep, voffB);
        PG8_WAIT_V(6); PG8_BAR;
    } else {
        PG8_STAGE(PG8_SB(0, 0), cB, voffB); PG8_STAGE(PG8_SA(0, 0), cA, voffA); PG8_STAGE(PG8_SB(0, 1), cB + hstep, voffB); PG8_STAGE(PG8_SA(0, 1), cA + hstep, voffA);
        if (wr == 1) PG8_BAR;
        PG8_WAIT_V(4); PG8_BAR;
        PG8_STAGE(PG8_SB(1, 0), cB + kstep, voffB); PG8_STAGE(PG8_SA(1, 0), cA + kstep, voffA); PG8_STAGE(PG8_SB(1, 1), cB + hstep + kstep, voffB);
        PG8_WAIT_V(6); PG8_BAR;
    }
    for (;;) {
        const bool has_next = S.next(ui + 1, nxt);
        const char* nA = has_next ? (const char*)g.A + (size_t)nxt.pm * tstep : cA; const char* nB = has_next ? (const char*)g.Bt + (size_t)nxt.pn * tstep : cB;
        for (int t = 0; t < nt; t += 2) {
            const bool last = (t == nt - 2);
            const char* a1 = cA + (size_t)(t + 1) * kstep;
            const char* a2 = last ? nA : cA + (size_t)(t + 2) * kstep; const char* b2 = last ? nB : cB + (size_t)(t + 2) * kstep;
            const char* a3 = a2 + kstep; const char* b3 = b2 + kstep;
            if (last && has_next) S.a_ready(nxt);
            if constexpr (SP2) {
            PG8_LDB(B0, 0, 0); PG8_LDB(B1, 0, 1); PG8_SCHED; PG8_LDA(At, 0, 0); PG8_STAGE(PG8_SA(1, 1), a1 + hstep, voffA);
            PG8_WAIT_V(8); PG8_WAIT_L(0); PG8_BAR; PG8_MMA(0, 0, At, B0); PG8_MMA(0, 1, At, B1); PG8_BAR; PG8_SCHED;
            PG8_LDA(At, 0, 1); PG8_STAGE(PG8_SB(0, 0), b2, voffB); PG8_STAGE(PG8_SB(0, 1), b2 + hstep, voffB); PG8_STAGE(PG8_SA(0, 0), a2, voffA);
            PG8_WAIT_V(8); PG8_WAIT_L(0); PG8_BAR; PG8_MMA(1, 0, At, B0); PG8_MMA(1, 1, At, B1); PG8_BAR; PG8_SCHED;
            PG8_LDB(B0, 1, 0); PG8_LDB(B1, 1, 1); PG8_SCHED; PG8_LDA(At, 1, 0); PG8_STAGE(PG8_SA(0, 1), a2 + hstep, voffA);
            PG8_WAIT_V(8); PG8_WAIT_L(0); PG8_BAR; PG8_MMA(0, 0, At, B0); PG8_MMA(0, 1, At, B1); PG8_BAR; PG8_SCHED;
            PG8_LDA(At, 1, 1); PG8_STAGE(PG8_SB(1, 0), b3, voffB); PG8_STAGE(PG8_SB(1, 1), b3 + hstep, voffB); PG8_STAGE(PG8_SA(1, 0), a3, voffA);
            PG8_WAIT_V(8); PG8_WAIT_L(0); PG8_BAR; PG8_MMA(1, 0, At, B0); PG8_MMA(1, 1, At, B1); PG8_BAR; PG8_SCHED;
            } else {
            PG8_LDB(B0, 0, 0); PG8_SCHED; PG8_LDA(At, 0, 0); PG8_STAGE(PG8_SA(1, 1), a1 + hstep, voffA);
            PG8_WAIT_L(8); PG8_BAR; PG8_WAIT_L(0); PG8_MMA(0, 0, At, B0); PG8_BAR; PG8_SCHED;
            PG8_LDB(B1, 0, 1); PG8_STAGE(PG8_SB(0, 0), b2, voffB);
            PG8_BAR; PG8_WAIT_L(0); PG8_MMA(0, 1, At, B1); PG8_BAR;
            PG8_LDA(At, 0, 1); PG8_STAGE(PG8_SA(0, 0), a2, voffA);
            PG8_BAR; PG8_WAIT_L(0); PG8_MMA(1, 0, At, B0); PG8_BAR; PG8_SCHED;
            PG8_STAGE(PG8_SB(0, 1), b2 + hstep, voffB);
            PG8_WAIT_V(6); PG8_BAR; PG8_MMA(1, 1, At, B1); PG8_BAR;
            PG8_LDB(B0, 1, 0); PG8_SCHED; PG8_LDA(At, 1, 0); PG8_STAGE(PG8_SA(0, 1), a2 + hstep, voffA);
            PG8_WAIT_L(8); PG8_BAR; PG8_WAIT_L(0); PG8_MMA(0, 0, At, B0); PG8_BAR; PG8_SCHED;
            PG8_LDB(B1, 1, 1); PG8_STAGE(PG8_SB(1, 0), b3, voffB);
            PG8_BAR; PG8_WAIT_L(0); PG8_MMA(0, 1, At, B1); PG8_BAR;
            PG8_LDA(At, 1, 1); PG8_STAGE(PG8_SA(1, 0), a3, voffA);
            PG8_BAR; PG8_WAIT_L(0); PG8_MMA(1, 0, At, B0); PG8_BAR; PG8_SCHED;
            PG8_STAGE(PG8_SB(1, 1), b3 + hstep, voffB);
            PG8_WAIT_V(6); PG8_BAR; PG8_MMA(1, 1, At, B1); PG8_BAR;
            }
        }
        if constexpr (ALIGN_EPI) { if (wr == 0) PG8_BAR; }
        E(acc, cur, (const PG8_LAS float*)(lds + (131072 + 1024)) + ui * 256, wr, wc, fr, fq); S.done(cur);
        if (!has_next) break;
#pragma unroll
        for (int a = 0; a < 2; ++a)
#pragma unroll
            for (int b = 0; b < 2; ++b)
#pragma unroll
                for (int m = 0; m < 4; ++m)
#pragma unroll
                    for (int n = 0; n < 2; ++n) acc[a][b][m][n] = (f32x4){0.f, 0.f, 0.f, 0.f};
        cur = nxt; cA = nA; cB = nB; ++ui;
        if constexpr (ALIGN_EPI) { if (wr == 1) PG8_BAR; }
    }
    PG8_WAIT_V(0);
    if constexpr (!ALIGN_EPI) { if (wr == 0) PG8_BAR; }
    PG8_BAR;
#undef PG8_SA
#undef PG8_SB
#undef PG8_STAGE
#undef PG8_LDA
#undef PG8_LDB
#undef PG8_MMA
#undef PG8_WAIT_V
#undef PG8_WAIT_L
#undef PG8_BAR
#undef PG8_SCHED
}
}

using pg8::bf16_t; using pg8::bf16x8; using pg8::f32x4; using pg8::u32x4; using pg8::u32x2; using pg8::cvt_pk_bf16;
#define LAS __attribute__((address_space(3)))
constexpr int NWAVES = 8;
constexpr int D = 1024, FF = 2816, WA = 512, WB = 512, PLE = 256, INW = 2048, DEPTH = 2;
constexpr int NB = 8, SEQ = 2048, MPR = NB * SEQ  , MS = 128  , MV = MPR + MS  , MP = 16640  ;
constexpr float EPS = 1e-6f;
constexpr size_t OW_GU1 = 0, OW_D1 = OW_GU1 + (size_t)2 * FF * D, OW_IN = OW_D1 + (size_t)D * FF, OW_OUT = OW_IN + (size_t)INW * D, OW_GU2 = OW_OUT + (size_t)D * D,
                 OW_D2 = OW_GU2 + (size_t)2 * FF * D, OW_PG = OW_D2 + (size_t)D * FF, OW_PP = OW_PG + (size_t)D * D, LW = OW_PP + (size_t)D * PLE;
constexpr size_t al256(size_t x) { return (x + 255) & ~(size_t)255; }
constexpr size_t WS_W = 1u << 20;
constexpr size_t WS_XB = al256(WS_W + 2 * LW * 2);
constexpr size_t WS_HZ = al256(WS_XB + (size_t)MP * D * 2);
constexpr size_t HZ_BYTES = (size_t)MP * FF * 2;
constexpr size_t WS_Y = al256(WS_HZ + HZ_BYTES);
constexpr size_t WS_PB = al256(WS_Y + (size_t)MP * D * 2);
constexpr size_t WS_SSQ = al256(WS_PB + (size_t)2 * MP * PLE * 2);
constexpr size_t WS_VST = al256(WS_SSQ + (size_t)MP * 16 * 4);
constexpr size_t WS_SSQ2 = al256(WS_VST + (size_t)MP * 16 * 4);
constexpr size_t WS_SSQS_A = al256(WS_SSQ2 + (size_t)MP * 16 * 4);
constexpr size_t WS_SSQS_B = WS_SSQS_A + 128 * 64 * 4;
constexpr size_t WS_VSTS = WS_SSQS_B + 128 * 64 * 4;
constexpr size_t WS_END = al256(WS_VSTS + 128 * 64 * 4);
static_assert((size_t)MP * 512 * 4 * 2 <= HZ_BYTES && (size_t)MP * D * 4 <= HZ_BYTES, "overlay");
constexpr size_t OO_YS = (size_t)MPR * D, OO_HP = OO_YS + (size_t)MS * D, OO_CP = OO_HP + (size_t)DEPTH * NB * WB, OO_HS = OO_CP + (size_t)DEPTH * NB * 3 * WB,
                 OO_CS = OO_HS + (size_t)DEPTH * MS * WB, OO_CV = OO_CS + (size_t)DEPTH * MS * 3 * WB, OO_END = OO_CV + (size_t)DEPTH * MS * WA;
constexpr int LDS_BYTES = 147456;

__device__ __forceinline__ float fsig(float x) { return __builtin_amdgcn_rcpf(1.f + __expf(-x)); }
__device__ __forceinline__ float fsilu(float x) { return x * fsig(x); }
__device__ __forceinline__ float fgelu(float x) { return x * fsig(1.5957691216f * (x + 0.044715f * x * x * x)); }
__device__ __forceinline__ float bf2f(unsigned short h) { return __builtin_bit_cast(float, (unsigned)h << 16); }
__device__ __forceinline__ unsigned short f2bf(float f) { return (unsigned short)(cvt_pk_bf16(f, 0.f) & 0xffffu); }
__device__ __forceinline__ float wave_sum(float v) {
#pragma unroll
    for (int o = 1; o < 64; o <<= 1) v += __shfl_xor(v, o);
    return v;
}
#define RS_LDS_OFF (131072 + 1024)
__device__ __forceinline__ float row_rstd(const float* ssq, int row, int fq) {
    const f32x4 a = *(const f32x4*)(ssq + (size_t)row * 16 + fq * 4);
    float s = (a.x + a.y) + (a.z + a.w);
    s += __shfl_xor(s, 16); s += __shfl_xor(s, 32);
    return rsqrtf(s * (1.f / D) + EPS);
}

struct EpiGU {
    static constexpr bool PERM = true;
    bf16_t* H; const float* ssq;
    __device__ __forceinline__ void operator()(const f32x4 (&acc)[2][2][4][2], const pg8::Unit& u, const LAS float* rsu, int wr, int wc, int fr, int fq) const {
        const int row0 = u.pm * 256 + wr * 64 + fr, col0 = u.pn * 128 + wc * 32 + 8 * fq;
#pragma unroll
        for (int ai = 0; ai < 2; ++ai)
#pragma unroll
            for (int m = 0; m < 4; ++m) {
                const int r = row0 + ai * 128 + m * 16; const float rs = rsu[ai * 128 + wr * 64 + m * 16 + fr];
                const f32x4 g0 = acc[ai][0][m][0] * rs, g1 = acc[ai][0][m][1] * rs, u0 = acc[ai][1][m][0] * rs, u1 = acc[ai][1][m][1] * rs;
                u32x4 w;
                w.x = cvt_pk_bf16(fsilu(g0[0]) * u0[0], fsilu(g0[1]) * u0[1]); w.y = cvt_pk_bf16(fsilu(g0[2]) * u0[2], fsilu(g0[3]) * u0[3]);
                w.z = cvt_pk_bf16(fsilu(g1[0]) * u1[0], fsilu(g1[1]) * u1[1]); w.w = cvt_pk_bf16(fsilu(g1[2]) * u1[2], fsilu(g1[3]) * u1[3]);
                *(u32x4*)(H + (size_t)r * FF + col0) = w;
            }
    }
};
__device__ __forceinline__ f32x4 unpk4(u32x2 w) { return (f32x4){__builtin_bit_cast(float, w.x << 16), __builtin_bit_cast(float, w.x & 0xffff0000u), __builtin_bit_cast(float, w.y << 16), __builtin_bit_cast(float, w.y & 0xffff0000u)}; }
template <int MODE> struct EpiRes {
    static constexpr bool PERM = true;
    const bf16_t* xin; bf16_t* xout; float* ssq_out; const float* ssq_in; const bf16_t* pp; float scale;
    __device__ __forceinline__ void operator()(const f32x4 (&acc)[2][2][4][2], const pg8::Unit& u, const LAS float* rsu, int wr, int wc, int fr, int fq) const {
        const int col0 = u.pn * 256 + wc * 32 + 8 * fq;
#pragma unroll
        for (int ai = 0; ai < 2; ++ai)
#pragma unroll
            for (int m = 0; m < 4; ++m) {
                const int r = u.pm * 256 + ai * 128 + wr * 64 + m * 16 + fr;
                float rs = 1.f; if (MODE == 1) rs = rsu[ai * 128 + wr * 64 + m * 16 + fr];
                float q = 0.f;
#pragma unroll
                for (int bj = 0; bj < 2; ++bj) {
                    const size_t off = (size_t)r * D + col0 + bj * 128;
                    const u32x4 bw = *(const u32x4*)(xin + off);
                    const f32x4 b0 = unpk4((u32x2){bw.x, bw.y}), b1 = unpk4((u32x2){bw.z, bw.w});
                    f32x4 o0, o1;
                    if (MODE == 0) { o0 = b0 + acc[ai][bj][m][0] * scale; o1 = b1 + acc[ai][bj][m][1] * scale; }
                    else { const u32x4 pw = *(const u32x4*)(pp + off); const f32x4 p0 = unpk4((u32x2){pw.x, pw.y}), p1 = unpk4((u32x2){pw.z, pw.w});
                           const f32x4 z0 = acc[ai][bj][m][0] * rs, z1 = acc[ai][bj][m][1] * rs;
                           o0 = b0 + (f32x4){fsig(z0[0]), fsig(z0[1]), fsig(z0[2]), fsig(z0[3])} * p0; o1 = b1 + (f32x4){fsig(z1[0]), fsig(z1[1]), fsig(z1[2]), fsig(z1[3])} * p1; }
                    u32x4 w; w.x = cvt_pk_bf16(o0[0], o0[1]); w.y = cvt_pk_bf16(o0[2], o0[3]); w.z = cvt_pk_bf16(o1[0], o1[1]); w.w = cvt_pk_bf16(o1[2], o1[3]);
                    *(u32x4*)(xout + off) = w;
                    const f32x4 r0 = unpk4((u32x2){w.x, w.y}), r1 = unpk4((u32x2){w.z, w.w});
                    q += ((r0[0] * r0[0] + r0[1] * r0[1]) + (r0[2] * r0[2] + r0[3] * r0[3])) + ((r1[0] * r1[0] + r1[1] * r1[1]) + (r1[2] * r1[2] + r1[3] * r1[3]));
                }
                q += __shfl_xor(q, 16); q += __shfl_xor(q, 32);
                if (fq == 0) ssq_out[(size_t)r * 16 + u.pn * 4 + wc] = q;
            }
    }
};
struct EpiWin {
    static constexpr bool PERM = true;
    bf16_t* Y; float* V; float* XR; float* vst; const float* ssq;
    __device__ __forceinline__ void operator()(const f32x4 (&acc)[2][2][4][2], const pg8::Unit& u, const LAS float* rsu, int wr, int wc, int fr, int fq) const {
        const int sec = u.pn >> 1, cb = (u.pn & 1) * 256 + wc * 32 + 8 * fq;
#pragma unroll
        for (int ai = 0; ai < 2; ++ai)
#pragma unroll
            for (int m = 0; m < 4; ++m) {
                const int r = u.pm * 256 + ai * 128 + wr * 64 + m * 16 + fr; const float rs = rsu[ai * 128 + wr * 64 + m * 16 + fr];
                float s1 = 0.f, s2 = 0.f;
#pragma unroll
                for (int bj = 0; bj < 2; ++bj) {
                    const int c = cb + bj * 128; const f32x4 z0 = acc[ai][bj][m][0] * rs, z1 = acc[ai][bj][m][1] * rs;
                    if (sec == 2) { *(f32x4*)(XR + (size_t)r * WB + c) = z0; *(f32x4*)(XR + (size_t)r * WB + c + 4) = z1; }
                    else {
                        const f32x4 g0 = (f32x4){fgelu(z0[0]), fgelu(z0[1]), fgelu(z0[2]), fgelu(z0[3])}, g1 = (f32x4){fgelu(z1[0]), fgelu(z1[1]), fgelu(z1[2]), fgelu(z1[3])};
                        if (sec == 1) { *(f32x4*)(V + (size_t)r * WA + c) = g0; *(f32x4*)(V + (size_t)r * WA + c + 4) = g1;
                            s1 += ((g0[0] + g0[1]) + (g0[2] + g0[3])) + ((g1[0] + g1[1]) + (g1[2] + g1[3]));
                            s2 += ((g0[0] * g0[0] + g0[1] * g0[1]) + (g0[2] * g0[2] + g0[3] * g0[3])) + ((g1[0] * g1[0] + g1[1] * g1[1]) + (g1[2] * g1[2] + g1[3] * g1[3])); }
                        else { u32x4 w; w.x = cvt_pk_bf16(g0[0], g0[1]); w.y = cvt_pk_bf16(g0[2], g0[3]); w.z = cvt_pk_bf16(g1[0], g1[1]); w.w = cvt_pk_bf16(g1[2], g1[3]);
                            *(u32x4*)(Y + (size_t)r * D + (sec == 3 ? 512 : 0) + c) = w; }
                    }
                }
                if (sec == 1) {
                    s1 += __shfl_xor(s1, 16); s1 += __shfl_xor(s1, 32); s2 += __shfl_xor(s2, 16); s2 += __shfl_xor(s2, 32);
                    if (fq == 0) { float* p = vst + (size_t)r * 16 + ((u.pn & 1) * 4 + wc) * 2; p[0] = s1; p[1] = s2; }
                }
            }
    }
};
struct EpiBf {
    static constexpr bool PERM = true;
    bf16_t* O;
    __device__ __forceinline__ void operator()(const f32x4 (&acc)[2][2][4][2], const pg8::Unit& u, const LAS float* rsu, int wr, int wc, int fr, int fq) const {
        const int col0 = u.pn * 256 + wc * 32 + 8 * fq;
#pragma unroll
        for (int ai = 0; ai < 2; ++ai)
#pragma unroll
            for (int m = 0; m < 4; ++m) {
                const int r = u.pm * 256 + ai * 128 + wr * 64 + m * 16 + fr;
#pragma unroll
                for (int bj = 0; bj < 2; ++bj) { const f32x4 v0 = acc[ai][bj][m][0], v1 = acc[ai][bj][m][1];
                    u32x4 w; w.x = cvt_pk_bf16(v0[0], v0[1]); w.y = cvt_pk_bf16(v0[2], v0[3]); w.z = cvt_pk_bf16(v1[0], v1[1]); w.w = cvt_pk_bf16(v1[2], v1[3]);
                    *(u32x4*)(O + (size_t)r * D + col0 + bj * 128) = w; }
            }
    }
};

struct Frame {
    LAS unsigned char* lds;
    int G, bid, wave, vcu;
    const float* const* in;
};
struct Args { const float* in[32]; float* out; unsigned char* ws; int ph_lo, ph_hi; };
typedef const Args CArgs;
__device__ __forceinline__ const CArgs* kargs() {
#if defined(__HIP_DEVICE_COMPILE__)
    auto p = __builtin_amdgcn_kernarg_segment_ptr(); asm volatile("" : "+s"(p)); return (const CArgs*)p;
#else
    return nullptr;
#endif
}

#define LOCAL_IDS int lane_l = (int)__builtin_amdgcn_mbcnt_hi(~0u, __builtin_amdgcn_mbcnt_lo(~0u, 0u)); asm volatile("" : "+v"(lane_l)); const int lane = lane_l, w = F.wave, tid = w * 64 + lane; (void)tid

#define XB_TMO      128
#define XB_XCNT(j)  (256  + 64 * (j))
#define XB_XSUB(j)  (1280 + 64 * (j))
#define XB_XGEN(j)  (2304 + 64 * (j))
#define XB_TOP      3328
#define XB_TOPGEN   3392
#define XCD_BAR_WORDS 3456
#define XB_SPIN_CAP (1u << 18)
__device__ __forceinline__ unsigned xb_ld(unsigned* p)              { return __hip_atomic_load(p, __ATOMIC_RELAXED, __HIP_MEMORY_SCOPE_AGENT); }
__device__ __forceinline__ unsigned xb_add(unsigned* p, unsigned v) { return __hip_atomic_fetch_add(p, v, __ATOMIC_RELAXED, __HIP_MEMORY_SCOPE_AGENT); }
__device__ __forceinline__ unsigned xb_xcc_id() { return (unsigned)__builtin_amdgcn_s_getreg((3 << 11) | 20) & 0xFu; }
#define XB_SPIN(cond, bar) do { unsigned _sp = 0; while (cond) { __builtin_amdgcn_s_sleep(1); \
    if ((++_sp & 255u) == 0u) { if (xb_ld(&(bar)[XB_TMO])) break; if (_sp > XB_SPIN_CAP) { atomicAdd(&(bar)[XB_TMO], 1u); break; } } } } while (0)
__device__ __forceinline__ void xcd_barrier_complete(unsigned* bar, unsigned x, unsigned G, unsigned& nloc, unsigned& nx) {
    unsigned sum, cnt, mine, sp = 0u;
    for (;;) {
        sum = 0u; cnt = 0u; mine = 0u;
#pragma unroll
        for (unsigned j = 0; j < 16; ++j) { const unsigned c = xb_ld(&bar[XB_XCNT(j)]); sum += c; cnt += (c > 0u) ? 1u : 0u; mine = (j == x) ? c : mine; }
        if (sum == G) break;
        __builtin_amdgcn_s_sleep(1);
        if ((++sp & 255u) == 0u) { if (xb_ld(&bar[XB_TMO])) break; if (sp > XB_SPIN_CAP) { atomicAdd(&bar[XB_TMO], 1u); break; } }
    }
    nloc = mine > 0u ? mine : 1u; nx = cnt > 0u ? cnt : 1u;
}
__device__ __forceinline__ void xcd_barrier(const Frame& F, unsigned* bar) {
    volatile LAS unsigned* st = (volatile LAS unsigned*)(F.lds + 131072 + 64);
    const int lane_b = (int)__builtin_amdgcn_mbcnt_hi(~0u, __builtin_amdgcn_mbcnt_lo(~0u, 0u));
    asm volatile("s_waitcnt vmcnt(0)" ::: "memory");
    __syncthreads();
    if (F.wave == 0 && lane_b == 0) {
        __builtin_amdgcn_s_waitcnt(0);
        const unsigned x = xb_xcc_id();
        unsigned nloc = st[0], nx = st[1];
        if (nloc == 0u) { xcd_barrier_complete(bar, x, (unsigned)F.G, nloc, nx); st[0] = nloc; st[1] = nx; }
        const unsigned old = xb_add(&bar[XB_XSUB(x)], 1u);
        const unsigned gen = old / nloc;
        if (old + 1u == (gen + 1u) * nloc) {
            __builtin_amdgcn_fence(__ATOMIC_RELEASE, "agent");
            asm volatile("s_waitcnt vmcnt(0)" ::: "memory");
            const unsigned og = xb_add(&bar[XB_TOP], 1u);
            const unsigned tg = og / nx;
            if (og + 1u == (tg + 1u) * nx) xb_add(&bar[XB_TOPGEN], 1u);
            else XB_SPIN(xb_ld(&bar[XB_TOPGEN]) == tg, bar);
            __builtin_amdgcn_fence(__ATOMIC_ACQUIRE, "agent");
            xb_add(&bar[XB_XGEN(x)], 1u);
            asm volatile("s_waitcnt vmcnt(0)" ::: "memory");
        } else {
            XB_SPIN(xb_ld(&bar[XB_XGEN(x)]) == gen, bar);
            __builtin_amdgcn_fence(__ATOMIC_ACQUIRE, "agent");
            asm volatile("s_waitcnt vmcnt(0)" ::: "memory");
        }
    }
    __syncthreads();
}
#define LDS_WAIT() asm volatile("s_waitcnt lgkmcnt(0)" ::: "memory")
#define LBAR() do { asm volatile("s_waitcnt lgkmcnt(0)" ::: "memory"); __builtin_amdgcn_s_barrier(); asm volatile("" ::: "memory"); } while (0)

struct TItem { const float* W; const float* gain; bf16_t* WT; int K, N, mode, item; };
__device__ __forceinline__ TItem p0_decode(const Args& a, bf16_t* Wb, int it) {
    constexpr int I_G = (D / 64) * (FF / 32), I_D = (FF / 64) * (D / 32), I_IN = (D / 64) * (INW / 32), I_O = (D / 64) * (D / 32), I_PP = (PLE / 64) * (D / 32);
    constexpr int PER_LAYER = 4 * I_G + 2 * I_D + I_IN + 2 * I_O + I_PP;
    const int l = it / PER_LAYER; int r = it % PER_LAYER; bf16_t* wl = Wb + (size_t)l * LW;
    if (r < I_G) return TItem{a.in[7] + (size_t)l * D * FF, a.in[6] + l * D, wl + OW_GU1, D, FF, 1, r}; r -= I_G;
    if (r < I_G) return TItem{a.in[8] + (size_t)l * D * FF, a.in[6] + l * D, wl + OW_GU1, D, FF, 2, r}; r -= I_G;
    if (r < I_D) return TItem{a.in[9] + (size_t)l * D * FF, nullptr, wl + OW_D1, FF, D, 0, r}; r -= I_D;
    if (r < I_IN) return TItem{a.in[11] + (size_t)l * D * INW, a.in[10] + l * D, wl + OW_IN, D, INW, 0, r}; r -= I_IN;
    if (r < I_O) return TItem{a.in[23] + (size_t)l * D * D, nullptr, wl + OW_OUT, D, D, 0, r}; r -= I_O;
    if (r < I_G) return TItem{a.in[25] + (size_t)l * D * FF, a.in[24] + l * D, wl + OW_GU2, D, FF, 1, r}; r -= I_G;
    if (r < I_G) return TItem{a.in[26] + (size_t)l * D * FF, a.in[24] + l * D, wl + OW_GU2, D, FF, 2, r}; r -= I_G;
    if (r < I_D) return TItem{a.in[27] + (size_t)l * D * FF, nullptr, wl + OW_D2, FF, D, 0, r}; r -= I_D;
    if (r < I_O) return TItem{a.in[29] + (size_t)l * D * D, a.in[28] + l * D, wl + OW_PG, D, D, 0, r}; r -= I_O;
    return TItem{a.in[30] + (size_t)l * PLE * D, nullptr, wl + OW_PP, PLE, D, 0, r};
}
__device__ __forceinline__ void ti_load(const TItem& t, int lane, float (&v)[32], f32x4 (&g)[2]) {
    const int nblk = t.N / 32, kb = t.item / nblk, nb = t.item % nblk, k0 = 64 * kb, n0 = 32 * nb;
    const float* p = t.W + (size_t)(k0 + (lane >> 5)) * t.N + n0 + (lane & 31);
#pragma unroll
    for (int i = 0; i < 32; ++i) v[i] = p[(size_t)(2 * i) * t.N];
    g[0] = (f32x4){1.f, 1.f, 1.f, 1.f}; g[1] = g[0];
    if (t.gain) { const f32x4* gp = (const f32x4*)(t.gain + k0 + 8 * (lane & 7)); g[0] = gp[0]; g[1] = gp[1]; }
}
__device__ __forceinline__ void ti_lds(LAS float* scr, int lane, const float (&v)[32]) {
#pragma unroll
    for (int i = 0; i < 32; ++i) scr[(2 * i + (lane >> 5)) * 33 + (lane & 31)] = v[i];
}
__device__ __forceinline__ void ti_store(const TItem& t, LAS float* scr, int lane, const f32x4 (&g)[2]) {
    const int nblk = t.N / 32, kb = t.item / nblk, nb = t.item % nblk, k0 = 64 * kb, n0 = 32 * nb;
    const int drow0 = t.mode == 0 ? n0 : (256 * (n0 >> 7) + (n0 & 127) + (t.mode == 2 ? 128 : 0));
    const int c = lane & 7;
    float sv[4][8];
#pragma unroll
    for (int j = 0; j < 4; ++j) { const LAS float* sp = scr + (8 * c) * 33 + (lane >> 3) + 8 * j;
#pragma unroll
        for (int e = 0; e < 8; ++e) sv[j][e] = sp[e * 33]; }
#pragma unroll
    for (int j = 0; j < 4; ++j) { const int n = (lane >> 3) + 8 * j;
        u32x4 o; o.x = cvt_pk_bf16(sv[j][0] * g[0].x, sv[j][1] * g[0].y); o.y = cvt_pk_bf16(sv[j][2] * g[0].z, sv[j][3] * g[0].w);
        o.z = cvt_pk_bf16(sv[j][4] * g[1].x, sv[j][5] * g[1].y); o.w = cvt_pk_bf16(sv[j][6] * g[1].z, sv[j][7] * g[1].w);
        *(u32x4*)(t.WT + (size_t)(drow0 + n) * t.K + k0 + 8 * c) = o; }
}

__device__ __forceinline__ void p0_prologue(const Frame& F) {
    const CArgs* ap = kargs(); const Args& a = *ap;
    LOCAL_IDS;
    LAS float* scr = (LAS float*)(F.lds + w * 16384);
    const int gw = F.bid * NWAVES + w, NGW = F.G * NWAVES;
    bf16_t* Wb = (bf16_t*)(a.ws + WS_W);
    constexpr int I_G = (D / 64) * (FF / 32), I_D = (FF / 64) * (D / 32), I_IN = (D / 64) * (INW / 32), I_O = (D / 64) * (D / 32), I_PP = (PLE / 64) * (D / 32);
    constexpr int NIT = DEPTH * (4 * I_G + 2 * I_D + I_IN + 2 * I_O + I_PP);
    if (gw < NIT) {
        int it = gw; TItem cur = p0_decode(a, Wb, it), nxt = cur; float v[32]; f32x4 g[2], g2[2]; ti_load(cur, lane, v, g);
        ti_lds(scr, lane, v);
        LDS_WAIT(); asm volatile("" ::: "memory");
        bool has = it + NGW < NIT; g2[0] = g[0]; g2[1] = g[1];
        if (has) { nxt = p0_decode(a, Wb, it + NGW); ti_load(nxt, lane, v, g2); }
        for (;;) {
            ti_store(cur, scr, lane, g);
            if (!has) break;
            LDS_WAIT(); asm volatile("" ::: "memory");
            ti_lds(scr, lane, v);
            LDS_WAIT(); asm volatile("" ::: "memory");
            cur = nxt; g[0] = g2[0]; g[1] = g2[1]; it += NGW;
            has = it + NGW < NIT;
            if (has) { nxt = p0_decode(a, Wb, it + NGW); ti_load(nxt, lane, v, g2); }
        }
        LDS_WAIT(); asm volatile("" ::: "memory");
    }
    bf16_t* XB = (bf16_t*)(a.ws + WS_Y); float* SSQ = (float*)(a.ws + WS_SSQ2);
    if (gw < MV) {
        int m = gw; f32x4 v[4]; float sq = 0.f; u32x2 wq[4];
#define X_LOAD(mm) do { const f32x4* xr_ = (const f32x4*)((mm) < MPR ? a.in[0] + (size_t)(mm) * D : a.in[1] + (size_t)((mm) - MPR) * D) + lane; \
        _Pragma("unroll") for (int j = 0; j < 4; ++j) v[j] = xr_[64 * j]; } while (0)
#define X_PACK() do { sq = 0.f; _Pragma("unroll") for (int j = 0; j < 4; ++j) { sq += (v[j].x * v[j].x + v[j].y * v[j].y) + (v[j].z * v[j].z + v[j].w * v[j].w); \
        wq[j].x = cvt_pk_bf16(v[j].x, v[j].y); wq[j].y = cvt_pk_bf16(v[j].z, v[j].w); } \
        asm volatile("" : "+v"(wq[0].x), "+v"(wq[0].y), "+v"(wq[1].x), "+v"(wq[1].y), "+v"(wq[2].x), "+v"(wq[2].y), "+v"(wq[3].x), "+v"(wq[3].y), "+v"(sq)); } while (0)
        X_LOAD(m); X_PACK();
        bool has = m + NGW < MV; if (has) X_LOAD(m + NGW);
        for (;;) {
            const float s = wave_sum(sq);
            u32x2* o8 = (u32x2*)(XB + (size_t)m * D) + lane;
#pragma unroll
            for (int j = 0; j < 4; ++j) o8[64 * j] = wq[j];
            if (m < MPR) { if (lane < 16) SSQ[(size_t)m * 16 + lane] = lane == 0 ? s : 0.f; }
            else ((float*)(a.ws + WS_SSQS_B))[(m - MPR) * 64 + lane] = lane == 0 ? s : 0.f;
            if (!has) break;
            m += NGW; X_PACK();
            has = m + NGW < MV; if (has) X_LOAD(m + NGW);
        }
#undef X_LOAD
#undef X_PACK
    }
    bf16_t* PB = (bf16_t*)(a.ws + WS_PB);
    if (gw < DEPTH * MV) {
        int i = gw; f32x4 v; u32x2 wq;
#define P_LOAD(ii) do { const int l_ = (ii) / MV, m_ = (ii) % MV; v = ((const f32x4*)(m_ < MPR ? a.in[4] + ((size_t)l_ * MPR + m_) * PLE : a.in[5] + ((size_t)l_ * MS + (m_ - MPR)) * PLE))[lane]; } while (0)
#define P_PACK() do { wq.x = cvt_pk_bf16(v.x, v.y); wq.y = cvt_pk_bf16(v.z, v.w); asm volatile("" : "+v"(wq.x), "+v"(wq.y)); } while (0)
        P_LOAD(i); P_PACK();
        bool has = i + NGW < DEPTH * MV; if (has) P_LOAD(i + NGW);
        for (;;) {
            ((u32x2*)(PB + ((size_t)(i / MV) * MP + (i % MV)) * PLE))[lane] = wq;
            if (!has) break;
            i += NGW; P_PACK();
            has = i + NGW < DEPTH * MV; if (has) P_LOAD(i + NGW);
        }
#undef P_LOAD
#undef P_PACK
    }
}

__device__ __forceinline__ void rglru_unit(const Frame& F, int l, int unit) {
    const CArgs* ap = kargs(); const Args& a = *ap;
    const int b = unit >> 5, hb = (unit >> 2) & 7, sub = unit & 3;
    LOCAL_IDS; const int fr = lane & 15, fq = lane >> 4;
    LAS bf16_t* XC = (LAS bf16_t*)F.lds;
    LAS float* XCF = (LAS float*)(F.lds + 18432);
    LAS float* SUM = (LAS float*)(F.lds + 18432 + 8192);
    const float* XR = (const float*)(a.ws + WS_HZ + (size_t)MP * WA * 4);
    bf16_t* Y = (bf16_t*)(a.ws + WS_Y);
    const size_t row0 = (size_t)b * SEQ;
    const int chh = hb * 64, ch = chh + sub * 16 + fr;
    const int c4 = (tid & 15) * 4, tk = tid >> 4;
    f32x4 cw[4];
#pragma unroll
    for (int k = 0; k < 4; ++k) cw[k] = *(const f32x4*)(a.in[16] + ((size_t)l * 4 + k) * WB + chh + c4);
    const f32x4 cbias = *(const f32x4*)(a.in[17] + (size_t)l * WB + chh + c4);
    bf16x8 Br[2], Bi[2];
    {
        const float* wrp = a.in[18] + ((size_t)(l * 8 + hb) * 64) * 64 + sub * 16 + fr;
        const float* wip = a.in[20] + ((size_t)(l * 8 + hb) * 64) * 64 + sub * 16 + fr;
#pragma unroll
        for (int ks = 0; ks < 2; ++ks)
#pragma unroll
            for (int e = 0; e < 8; e += 2) {
                const int i0 = 32 * ks + 8 * fq + e;
                const unsigned pr = cvt_pk_bf16(wrp[(size_t)i0 * 64], wrp[(size_t)(i0 + 1) * 64]), pi = cvt_pk_bf16(wip[(size_t)i0 * 64], wip[(size_t)(i0 + 1) * 64]);
                Br[ks][e] = (short)(pr & 0xffffu); Br[ks][e + 1] = (short)(pr >> 16); Bi[ks][e] = (short)(pi & 0xffffu); Bi[ks][e + 1] = (short)(pi >> 16);
            }
    }
    const float br = a.in[19][l * WB + ch], bi = a.in[21][l * WB + ch];
    const float c8 = -8.f * log1pf(expf(-a.in[22][l * WB + ch]));
    const int tg = tid >> 4;
    f32x4 xr[11];
#define RG_LOAD(it_) do { _Pragma("unroll") for (int i2 = 0; i2 < 11; ++i2) { const int tt = 256 * (it_) + 8 * tg - 3 + i2; \
        xr[i2] = tt >= 0 ? *(const f32x4*)(XR + (row0 + tt) * WB + chh + c4) : (f32x4){0.f, 0.f, 0.f, 0.f}; } } while (0)
    LAS bf16_t* XC2 = (LAS bf16_t*)F.lds;
    LAS float* XCF2 = (LAS float*)(F.lds + 73728);
    LAS float* SUM2 = (LAS float*)(F.lds + 73728 + 32768);
#define RG_CONV(P) do { LAS bf16_t* XCw = XC2 + (P) * 18432; LAS float* XCFw = XCF2 + (P) * 4096; \
        _Pragma("unroll") for (int j2 = 0; j2 < 8; ++j2) { f32x4 xc = cbias; \
            _Pragma("unroll") for (int k = 0; k < 4; ++k) xc += xr[j2 + k] * cw[k]; \
            const int tok = 8 * tg + j2; u32x2 pk; pk.x = cvt_pk_bf16(xc[0], xc[1]); pk.y = cvt_pk_bf16(xc[2], xc[3]); \
            *(LAS u32x2*)(XCw + tok * 72 + c4) = pk; if ((c4 >> 4) == sub) *(LAS f32x4*)(XCFw + tok * 16 + (c4 & 15)) = xc; } } while (0)
    RG_LOAD(0);
    float hcar = 0.f;
    LBAR();
    RG_CONV(0);
    RG_LOAD(1);
    LBAR();
    for (int it = 0; it < SEQ / 256; ++it) {
        const LAS bf16_t* XCr = XC2 + (it & 1) * 18432; const LAS float* XCFr = XCF2 + (it & 1) * 4096; LAS float* SUMr = SUM2 + (it & 1) * 256;
        bf16_t* yp = Y + (row0 + 256 * it + 32 * w + 4 * fq) * D + 512 + ch;
        float gt[2][4];
#pragma unroll
        for (int t2 = 0; t2 < 2; ++t2)
#pragma unroll
            for (int j2 = 0; j2 < 4; ++j2) gt[t2][j2] = bf2f(yp[(size_t)(16 * t2 + j2) * D]);
        float Pj[2][4], Hj[2][4], Pl[2], Hl[2], Pe[2], He[2];
#pragma unroll
        for (int t2 = 0; t2 < 2; ++t2) {
            const int trow = 32 * w + 16 * t2;
            const bf16x8 a0 = *(const LAS bf16x8*)(XCr + (trow + fr) * 72 + 8 * fq), a1 = *(const LAS bf16x8*)(XCr + (trow + fr) * 72 + 32 + 8 * fq);
            f32x4 accr = (f32x4){0.f, 0.f, 0.f, 0.f}, acci = (f32x4){0.f, 0.f, 0.f, 0.f};
            accr = __builtin_amdgcn_mfma_f32_16x16x32_bf16(a0, Br[0], accr, 0, 0, 0); accr = __builtin_amdgcn_mfma_f32_16x16x32_bf16(a1, Br[1], accr, 0, 0, 0);
            acci = __builtin_amdgcn_mfma_f32_16x16x32_bf16(a0, Bi[0], acci, 0, 0, 0); acci = __builtin_amdgcn_mfma_f32_16x16x32_bf16(a1, Bi[1], acci, 0, 0, 0);
#pragma unroll
            for (int j2 = 0; j2 < 4; ++j2) {
                const float xcf = XCFr[(trow + 4 * fq + j2) * 16 + fr];
                const float rg = fsig(accr[j2] + br), ig = fsig(acci[j2] + bi);
                const float la = c8 * rg, av = __expf(la), uv = sqrtf(fmaxf(1.f - __expf(2.f * la), 0.f)) * (ig * xcf);
                if (j2 == 0) { Pj[t2][0] = av; Hj[t2][0] = uv; } else { Pj[t2][j2] = av * Pj[t2][j2 - 1]; Hj[t2][j2] = av * Hj[t2][j2 - 1] + uv; }
            }
            Pl[t2] = Pj[t2][3]; Hl[t2] = Hj[t2][3];
        }
#pragma unroll
        for (int t2 = 0; t2 < 2; ++t2) {
            float Pp = __shfl_up(Pl[t2], 16), Hp = __shfl_up(Hl[t2], 16);
            if (fq >= 1) { Hl[t2] = Pl[t2] * Hp + Hl[t2]; Pl[t2] = Pl[t2] * Pp; }
            Pp = __shfl_up(Pl[t2], 32); Hp = __shfl_up(Hl[t2], 32);
            if (fq >= 2) { Hl[t2] = Pl[t2] * Hp + Hl[t2]; Pl[t2] = Pl[t2] * Pp; }
            Pe[t2] = __shfl_up(Pl[t2], 16); He[t2] = __shfl_up(Hl[t2], 16);
            if (fq == 0) { Pe[t2] = 1.f; He[t2] = 0.f; }
        }
        const float P0t = __shfl(Pl[0], 48 + fr), H0t = __shfl(Hl[0], 48 + fr);
        if (fq == 3) { SUMr[(w * 16 + fr) * 2] = Pl[1] * P0t; SUMr[(w * 16 + fr) * 2 + 1] = Pl[1] * H0t + Hl[1]; }
        if (it + 1 < SEQ / 256) { RG_CONV((it & 1) ^ 1); if (it + 2 < SEQ / 256) RG_LOAD(it + 2); }
        LBAR();
        float carry = hcar, cwv = hcar;
#pragma unroll
        for (int w2 = 0; w2 < 8; ++w2) { const float Pw = SUMr[(w2 * 16 + fr) * 2], Hw = SUMr[(w2 * 16 + fr) * 2 + 1]; if (w2 == w) cwv = carry; carry = Pw * carry + Hw; }
        hcar = carry;
        const float c1w = P0t * cwv + H0t;
#pragma unroll
        for (int t2 = 0; t2 < 2; ++t2) {
            const float cl = Pe[t2] * (t2 == 0 ? cwv : c1w) + He[t2];
#pragma unroll
            for (int j2 = 0; j2 < 4; ++j2) { const float h = Pj[t2][j2] * cl + Hj[t2][j2]; yp[(size_t)(16 * t2 + j2) * D] = f2bf(h * gt[t2][j2]); }
        }
    }
#undef RG_CONV
#undef RG_LOAD
    if (w == 0 && fq == 0) a.out[OO_HP + ((size_t)l * NB + b) * WB + ch] = hcar;
    if (tid < 48) { const int k = tid >> 4, c = chh + sub * 16 + (tid & 15);
        a.out[OO_CP + (((size_t)l * NB + b) * 3 + k) * WB + c] = XR[(row0 + SEQ - 3 + k) * WB + c]; }
}

__device__ __forceinline__ void gmlp_units(const Frame& F, int l) {
    const CArgs* ap = kargs(); const Args& a = *ap;
    LOCAL_IDS; const int fr = lane & 15, fq = lane >> 4;
    constexpr int NU = NB * 16 * 8;
    int u = F.bid, ustep = F.G, uend = NU;
    if (F.G == 256) { const int x = F.bid & 7, j = F.bid >> 3; u = x * 128 + (j >> 3) * 8 + (j & 7); ustep = 32; uend = x * 128 + 128; }
    if (u >= uend) return;
    LAS bf16_t* VT = (LAS bf16_t*)F.lds;
    const float* V = (const float*)(a.ws + WS_HZ); const float* VST = (const float*)(a.ws + WS_VST);
    bf16_t* Y = (bf16_t*)(a.ws + WS_Y);
    const int irow = 16 * w + fr, tok = tid >> 2, d0 = (tid & 3) * 16;
    int hc = -1; bf16x8 Wf[4]; f32x4 gq[4], bq[4]; float bs = 0.f;
    f32x4 st, vv[4]; u32x2 uv[4], uvc[4];
#define G_CONST(h_) do { hc = (h_); const float* wsp = a.in[14] + (((size_t)l * 8 + hc) * 128 + irow) * 128; \
        _Pragma("unroll") for (int ks = 0; ks < 4; ++ks) { \
            if (ks <= (w >> 1)) { const int j0 = 32 * ks + 8 * fq; const f32x4 w0 = *(const f32x4*)(wsp + j0), w1 = *(const f32x4*)(wsp + j0 + 4); \
                float e[8] = {w0[0], w0[1], w0[2], w0[3], w1[0], w1[1], w1[2], w1[3]}; \
                _Pragma("unroll") for (int q = 0; q < 8; q += 2) { const unsigned pk = cvt_pk_bf16(j0 + q <= irow ? e[q] : 0.f, j0 + q + 1 <= irow ? e[q + 1] : 0.f); Wf[ks][q] = (short)(pk & 0xffffu); Wf[ks][q + 1] = (short)(pk >> 16); } \
            } else { Wf[ks] = (bf16x8){0, 0, 0, 0, 0, 0, 0, 0}; } } \
        _Pragma("unroll") for (int q = 0; q < 4; ++q) { gq[q] = *(const f32x4*)(a.in[12] + (size_t)l * WA + hc * 64 + 16 * q + (d0 >> 2)); bq[q] = *(const f32x4*)(a.in[13] + (size_t)l * WA + hc * 64 + 16 * q + (d0 >> 2)); } \
        bs = a.in[15][((size_t)l * 8 + hc) * 128 + irow]; } while (0)
#define G_LOAD(uu) do { const int h_ = (uu) & 7; const size_t r0_ = (size_t)((uu) >> 3) * 128, row_ = r0_ + tok; \
        st = *(const f32x4*)(VST + row_ * 16 + (tid & 3) * 4); \
        _Pragma("unroll") for (int q = 0; q < 4; ++q) vv[q] = *(const f32x4*)(V + row_ * WA + h_ * 64 + 16 * q + (d0 >> 2)); \
        const bf16_t* yp_ = Y + (r0_ + irow) * D + h_ * 64 + 4 * fq; \
        _Pragma("unroll") for (int nt = 0; nt < 4; ++nt) uv[nt] = *(const u32x2*)(yp_ + 16 * nt); } while (0)
#define G_LN() do { float s1 = st[0] + st[2], s2 = st[1] + st[3]; \
        s1 += __shfl_xor(s1, 1); s1 += __shfl_xor(s1, 2); s2 += __shfl_xor(s2, 1); s2 += __shfl_xor(s2, 2); \
        const float mean = s1 * (1.f / WA), rstd = rsqrtf(fmaxf(s2 * (1.f / WA) - mean * mean, 0.f) + EPS); \
        _Pragma("unroll") for (int q = 0; q < 4; ++q) { const f32x4 o = (vv[q] - mean) * rstd * gq[q] + bq[q]; \
            _Pragma("unroll") for (int e = 0; e < 4; ++e) VT[(16 * q + (d0 >> 2) + e) * 136 + tok] = f2bf(o[e]); } \
        _Pragma("unroll") for (int nt = 0; nt < 4; ++nt) uvc[nt] = uv[nt]; } while (0)
    G_LOAD(u); G_CONST(u & 7);
    LBAR();
    G_LN();
    bool has = u + ustep < uend; if (has) G_LOAD(u + ustep);
    for (;;) {
        LBAR();
        f32x4 acc[4];
#pragma unroll
        for (int nt = 0; nt < 4; ++nt) acc[nt] = (f32x4){0.f, 0.f, 0.f, 0.f};
#pragma unroll
        for (int ks = 0; ks < 4; ++ks) {
            if (ks <= (w >> 1)) {
#pragma unroll
                for (int nt = 0; nt < 4; ++nt) {
                    const bf16x8 av = *(const LAS bf16x8*)(VT + (16 * nt + fr) * 136 + 32 * ks + 8 * fq);
                    acc[nt] = __builtin_amdgcn_mfma_f32_16x16x32_bf16(av, Wf[ks], acc[nt], 0, 0, 0);
                }
            }
        }
        LBAR();
        bf16_t* yp = Y + ((size_t)(u >> 3) * 128 + irow) * D + (u & 7) * 64 + 4 * fq;
#pragma unroll
        for (int nt = 0; nt < 4; ++nt) {
            const float u0 = bf2f((unsigned short)(uvc[nt].x & 0xffffu)), u1 = bf2f((unsigned short)(uvc[nt].x >> 16)), u2 = bf2f((unsigned short)(uvc[nt].y & 0xffffu)), u3 = bf2f((unsigned short)(uvc[nt].y >> 16));
            u32x2 o; o.x = cvt_pk_bf16(u0 * (acc[nt][0] + bs), u1 * (acc[nt][1] + bs)); o.y = cvt_pk_bf16(u2 * (acc[nt][2] + bs), u3 * (acc[nt][3] + bs));
            *(u32x2*)(yp + 16 * nt) = o;
        }
        if (!has) break;
        u += ustep;
        if ((u & 7) != hc) G_CONST(u & 7);
        G_LN();
        has = u + ustep < uend; if (has) G_LOAD(u + ustep);
    }
#undef G_CONST
#undef G_LOAD
#undef G_LN
}

__device__ __forceinline__ float sum16(float s) { s += __shfl_xor(s, 1); s += __shfl_xor(s, 2); s += __shfl_xor(s, 4); s += __shfl_xor(s, 8); return s; }
__device__ __forceinline__ void sample_mix_unit(const Frame& F, int l, int sb) {
    const CArgs* ap = kargs(); const Args& a = *ap;
    LOCAL_IDS; const int c = tid;
    LAS float* xcs = (LAS float*)F.lds;
    const size_t row = (size_t)MPR + sb;
    const float* V = (const float*)(a.ws + WS_HZ); const float* XR = (const float*)(a.ws + WS_HZ + (size_t)MP * WA * 4); const float* VST = (const float*)(a.ws + WS_VSTS);
    bf16_t* Y = (bf16_t*)(a.ws + WS_Y);
    const int h = c >> 6, j = c & 63;
    const f32x4 stp = *(const f32x4*)(VST + sb * 64 + (c & 15) * 4);
    const float vraw = V[row * WA + c], lng = a.in[12][l * WA + c], lnb = a.in[13][l * WA + c];
    const float ws00 = a.in[14][((size_t)l * 8 + h) * 128 * 128], bs0 = a.in[15][((size_t)l * 8 + h) * 128];
    const float yu = bf2f(Y[row * D + c]), yg = bf2f(Y[row * D + 512 + c]);
    const float xr = XR[row * WB + c];
    const float* sc = a.in[3] + ((size_t)l * MS + sb) * 3 * WB;
    const float b0 = sc[c], b1 = sc[WB + c], b2 = sc[2 * WB + c];
    const float* cwp = a.in[16] + (size_t)l * 4 * WB;
    const float cw0 = cwp[c], cw1 = cwp[WB + c], cw2 = cwp[2 * WB + c], cw3 = cwp[3 * WB + c], cbv = a.in[17][l * WB + c];
    const float brv = a.in[19][l * WB + c], biv = a.in[21][l * WB + c], lamv = a.in[22][l * WB + c], h0 = a.in[2][((size_t)l * MS + sb) * WB + c];
    const float* wrp = a.in[18] + ((size_t)(l * 8 + h) * 64) * 64 + j; const float* wip = a.in[20] + ((size_t)(l * 8 + h) * 64) * 64 + j;
    float wrv[64], wiv[64];
#pragma unroll
    for (int i = 0; i < 64; ++i) { wrv[i] = wrp[(size_t)i * 64]; wiv[i] = wip[(size_t)i * 64]; }
    const float s1 = sum16(stp.x + stp.z), s2 = sum16(stp.y + stp.w);
    const float mean = s1 * (1.f / WA), rstd = rsqrtf(fmaxf(s2 * (1.f / WA) - mean * mean, 0.f) + EPS);
    const float vln = (vraw - mean) * rstd * lng + lnb;
    const float sg = ws00 * vln + bs0;
    const float xc = cbv + b0 * cw0 + b1 * cw1 + b2 * cw2 + xr * cw3;
    LBAR();
    xcs[c] = xc;
    LBAR();
    float ar = brv, ai = biv;
#pragma unroll
    for (int i = 0; i < 64; ++i) { const float x = xcs[h * 64 + i]; ar += x * wrv[i]; ai += x * wiv[i]; }
    const float rg = fsig(ar), ig = fsig(ai);
    const float la = -8.f * log1pf(expf(-lamv)) * rg;
    const float av = __expf(la), uv = sqrtf(fmaxf(1.f - __expf(2.f * la), 0.f)) * (ig * xc);
    const float hn = av * h0 + uv;
    a.out[OO_CV + ((size_t)l * MS + sb) * WA + c] = vln;
    Y[row * D + c] = f2bf(yu * sg);
    a.out[OO_HS + ((size_t)l * MS + sb) * WB + c] = hn;
    float* co = a.out + OO_CS + ((size_t)l * MS + sb) * 3 * WB;
    co[c] = b1; co[WB + c] = b2; co[2 * WB + c] = xr;
    Y[row * D + 512 + c] = f2bf(hn * yg);
}

constexpr int N_PHASES = 2 + 8 * DEPTH;


template <int NBM, int BATCH = (NBM == 1 ? 12 : 6)>
__device__ __forceinline__ void mini_core(LAS unsigned char* lds, const bf16_t* Arow, int lda, const bf16_t* B0, const bf16_t* B1, int K, int w, int lane, float& v0, float& v1) {
    const int fr = lane & 15, fq = lane >> 4;
    const int Kw = K >> 3, nsteps = Kw >> 5, k0 = w * Kw + 8 * fq;
    const bf16_t* pa0 = Arow + (size_t)fr * lda + k0; const bf16_t* pa1 = pa0 + (size_t)16 * lda;
    const bf16_t* pb0 = B0 + (size_t)fr * K + k0; const bf16_t* pb1 = B1 + (size_t)fr * K + k0;
    f32x4 acc00 = (f32x4){0.f, 0.f, 0.f, 0.f}, acc01 = acc00, acc10 = acc00, acc11 = acc00;
    for (int s0 = 0; s0 < nsteps; s0 += BATCH) {
        bf16x8 a0[BATCH], a1[BATCH], b0[BATCH], b1[BATCH];
#pragma unroll
        for (int i = 0; i < BATCH; ++i) if (s0 + i < nsteps) { const int ko = (s0 + i) * 32;
            a0[i] = *(const bf16x8*)(pa0 + ko); a1[i] = *(const bf16x8*)(pa1 + ko); b0[i] = *(const bf16x8*)(pb0 + ko); if (NBM == 2) b1[i] = *(const bf16x8*)(pb1 + ko); }
#pragma unroll
        for (int i = 0; i < BATCH; ++i) if (s0 + i < nsteps) {
            acc00 = __builtin_amdgcn_mfma_f32_16x16x32_bf16(b0[i], a0[i], acc00, 0, 0, 0); acc01 = __builtin_amdgcn_mfma_f32_16x16x32_bf16(b0[i], a1[i], acc01, 0, 0, 0);
            if (NBM == 2) { acc10 = __builtin_amdgcn_mfma_f32_16x16x32_bf16(b1[i], a0[i], acc10, 0, 0, 0); acc11 = __builtin_amdgcn_mfma_f32_16x16x32_bf16(b1[i], a1[i], acc11, 0, 0, 0); } }
    }
    LAS float* P = (LAS float*)lds;
    *(LAS f32x4*)(P + ((0 * 8 + w) * 32 + fr) * 16 + 4 * fq) = acc00; *(LAS f32x4*)(P + ((0 * 8 + w) * 32 + 16 + fr) * 16 + 4 * fq) = acc01;
    if (NBM == 2) { *(LAS f32x4*)(P + ((8 + w) * 32 + fr) * 16 + 4 * fq) = acc10; *(LAS f32x4*)(P + ((8 + w) * 32 + 16 + fr) * 16 + 4 * fq) = acc11; }
    LBAR();
    const int t = w * 64 + lane; float s0_ = 0.f, s1_ = 0.f;
#pragma unroll
    for (int w2 = 0; w2 < 8; ++w2) { s0_ += P[w2 * 512 + t]; if (NBM == 2) s1_ += P[(8 + w2) * 512 + t]; }
    v0 = s0_; v1 = s1_;
    LBAR();
}
__device__ __forceinline__ float srow_rstd(const float* ssqs, int srow, int col) {
    const f32x4 a = *(const f32x4*)(ssqs + srow * 64 + col * 4); float s = (a.x + a.y) + (a.z + a.w);
    s += __shfl_xor(s, 1); s += __shfl_xor(s, 2); s += __shfl_xor(s, 4); s += __shfl_xor(s, 8);
    return rsqrtf(s * (1.f / D) + EPS);
}

__device__ __forceinline__ void mini_gu(const Frame& F, const bf16_t* Ain, const bf16_t* Wgu, const float* ssqs, bf16_t* H, int mu) {
    LOCAL_IDS; const int rg = mu & 3, c0 = (mu >> 2) * 16, row = tid >> 4, col = tid & 15;
    const bf16_t* B0 = Wgu + (size_t)(256 * (c0 >> 7) + (c0 & 127)) * D;
    const float rs = srow_rstd(ssqs, 32 * rg + row, col);
    float g, u; mini_core<2>(F.lds, Ain + (size_t)(MPR + 32 * rg) * D, D, B0, B0 + (size_t)128 * D, D, w, lane, g, u);
    H[(size_t)(MPR + 32 * rg + row) * FF + c0 + col] = f2bf(fsilu(g * rs) * (u * rs));
}
template <int MODE>
__device__ __forceinline__ void mini_res(const Frame& F, const bf16_t* Ain, int K, const bf16_t* W, const bf16_t* xin, bf16_t* xout, float* ssqs_out, float scale,
                                         const float* ssqs_in, const bf16_t* Pin, const bf16_t* Wp, int mu) {
    LOCAL_IDS; const int rg = mu & 3, cg = mu >> 2, c0 = cg * 16, row = tid >> 4, col = tid & 15;
    const size_t off = (size_t)(MPR + 32 * rg + row) * D + c0 + col;
    const float xb0 = bf2f(xin[off]); float rs = 1.f; if (MODE == 1) rs = srow_rstd(ssqs_in, 32 * rg + row, col);
    float v, dummy; mini_core<1>(F.lds, Ain + (size_t)(MPR + 32 * rg) * K, K, W + (size_t)c0 * K, W + (size_t)c0 * K, K, w, lane, v, dummy);
    float o;
    if (MODE == 0) o = xb0 + scale * v;
    else { float pv; mini_core<1>(F.lds, Pin + (size_t)(MPR + 32 * rg) * PLE, PLE, Wp + (size_t)c0 * PLE, Wp + (size_t)c0 * PLE, PLE, w, lane, pv, dummy);
           o = xb0 + fsig(v * rs) * pv; }
    const unsigned short ob = f2bf(o); xout[off] = ob;
    const float orr = bf2f(ob), q = sum16(orr * orr);
    if (col == 0) ssqs_out[(32 * rg + row) * 64 + cg] = q;
}
__device__ __forceinline__ void mini_win(const Frame& F, const bf16_t* Ain, const bf16_t* W, const float* ssqs, bf16_t* Y, float* V, float* XR, float* vsts, int mu) {
    LOCAL_IDS; const int rg = mu & 3, cg = mu >> 2, c0 = cg * 16, row = tid >> 4, col = tid & 15;
    const float rsw = srow_rstd(ssqs, 32 * rg + row, col);
    float v, dummy; mini_core<1>(F.lds, Ain + (size_t)(MPR + 32 * rg) * D, D, W + (size_t)c0 * D, W + (size_t)c0 * D, D, w, lane, v, dummy);
    const float z = v * rsw;
    const int sec = c0 >> 9, cc = (c0 & 511) + col; const size_t r = (size_t)MPR + 32 * rg + row;
    if (sec == 2) XR[r * WB + cc] = z;
    else { const float gz = fgelu(z);
        if (sec == 0) Y[r * D + cc] = f2bf(gz);
        else if (sec == 3) Y[r * D + 512 + cc] = f2bf(gz);
        else { V[r * WA + cc] = gz; const float s1 = sum16(gz), s2 = sum16(gz * gz); if (col == 0) { float* p = vsts + (32 * rg + row) * 64 + ((c0 & 511) >> 4) * 2; p[0] = s1; p[1] = s2; } } }
}


template <int MAXU>
__device__ __forceinline__ void stage_rs(const Frame& F, const float* ssq, const pg8::StaticOrder& S) {
    LOCAL_IDS;
    LAS float* RS = (LAS float*)(F.lds + RS_LDS_OFF);
    f32x4 pa[MAXU][2]; bool ok[MAXU];
#pragma unroll
    for (int i = 0; i < MAXU; ++i) { pg8::Unit u; ok[i] = S.next(i, u);
        if (ok[i]) { const f32x4* p = (const f32x4*)(ssq + (size_t)(u.pm * 256 + (tid >> 1)) * 16 + (tid & 1) * 8); pa[i][0] = p[0]; pa[i][1] = p[1]; } }
#pragma unroll
    for (int i = 0; i < MAXU; ++i) if (ok[i]) {
        float sm = ((pa[i][0].x + pa[i][0].y) + (pa[i][0].z + pa[i][0].w)) + ((pa[i][1].x + pa[i][1].y) + (pa[i][1].z + pa[i][1].w));
        sm += __shfl_xor(sm, 1);
        if ((tid & 1) == 0) RS[i * 256 + (tid >> 1)] = rsqrtf(sm * (1.f / D) + EPS); }
    LBAR();
}

#define IN(k) (lo <= (k) && (k) < hi)
#define SEAM(k) do { if (IN(k) && IN((k) + 1)) xcd_barrier(F, (unsigned*)(kargs()->ws)); } while (0)
#define WS_PTRS const CArgs* ap = kargs(); unsigned char* ws = ap->ws; float* xres = ap->out; bf16_t* wl = (bf16_t*)(ws + WS_W) + (size_t)l * LW; \
    bf16_t* XB = (bf16_t*)(ws + WS_XB); bf16_t* HB = (bf16_t*)(ws + WS_HZ); bf16_t* YB = (bf16_t*)(ws + WS_Y); float* SSQ = (float*)(ws + WS_SSQ); \
    (void)xres; (void)wl; (void)XB; (void)HB; (void)YB; (void)SSQ
#define MINI_GU(Ain, Wgu, ssqs) do { const int half = F.G / 2; if (F.bid >= half) for (int mu = F.bid - half; mu < 4 * (FF / 16); mu += F.G - half) mini_gu(F, Ain, Wgu, ssqs, HB, mu); } while (0)
template <int l> __device__ __forceinline__ void layer_phases(const Frame& F, const int lo, const int hi) {
        const int pb = 1 + 8 * l;
        if (IN(pb + 0)) {
            WS_PTRS; pg8::Gemm g{YB, wl + OW_GU1, MPR, 2 * FF, D}; pg8::StaticOrder S; S.init(MPR, 2 * FF, F.G, F.bid); EpiGU E{HB, (const float*)(ws + WS_SSQ2)};
            stage_rs<6>(F, (const float*)(ws + WS_SSQ2), S);
            pg8::gemm_phase<EpiGU, pg8::StaticOrder, true, true>(F.lds, g, S, E, F.wave);
            MINI_GU(YB, wl + OW_GU1, (const float*)(ws + WS_SSQS_B)); }
        SEAM(pb + 0);
        if (IN(pb + 1)) {
            WS_PTRS; pg8::Gemm g{HB, wl + OW_D1, MPR, D, FF}; pg8::StaticOrder S; S.init(MPR, D, F.G, F.bid);
            EpiRes<0> E{YB, XB, SSQ, nullptr, nullptr, 0.5f};
            pg8::gemm_phase<EpiRes<0>, pg8::StaticOrder, true, true>(F.lds, g, S, E, F.wave);
            for (int mu = F.vcu; mu < 256; mu += F.G) mini_res<0>(F, HB, FF, wl + OW_D1, YB, XB, (float*)(ws + WS_SSQS_A), 0.5f, nullptr, nullptr, nullptr, mu); }
        SEAM(pb + 1);
        if (IN(pb + 2)) {
            WS_PTRS; pg8::Gemm g{XB, wl + OW_IN, MPR, INW, D}; pg8::StaticOrder S; S.init(MPR, INW, F.G, F.bid);
            EpiWin E{YB, (float*)(ws + WS_HZ), (float*)(ws + WS_HZ + (size_t)MP * WA * 4), (float*)(ws + WS_VST), SSQ};
            stage_rs<2>(F, SSQ, S);
            pg8::gemm_phase<EpiWin, pg8::StaticOrder, true, true>(F.lds, g, S, E, F.wave);
            for (int mu = F.vcu; mu < 512; mu += F.G) mini_win(F, XB, wl + OW_IN, (const float*)(ws + WS_SSQS_A), YB, (float*)(ws + WS_HZ), (float*)(ws + WS_HZ + (size_t)MP * WA * 4), (float*)(ws + WS_VSTS), mu); }
        SEAM(pb + 2);
        if (IN(pb + 3)) {
            {
                const int vcu = (F.G % 8 == 0) ? (F.bid % 8) * (F.G / 8) + F.bid / 8 : F.bid;
                for (int u = vcu; u < NB * 8 * 4; u += F.G) rglru_unit(F, l, u); }
            gmlp_units(F, l);
            for (int u = F.bid; u < MS; u += F.G) sample_mix_unit(F, l, u);
            LBAR(); }
        SEAM(pb + 3);
        if (IN(pb + 4)) {
            WS_PTRS; pg8::Gemm g{YB, wl + OW_OUT, MPR, D, D}; pg8::StaticOrder S; S.init(MPR, D, F.G, F.bid);
            EpiRes<0> E{XB, XB, SSQ, nullptr, nullptr, 1.0f};
            pg8::gemm_phase<EpiRes<0>, pg8::StaticOrder, true, true>(F.lds, g, S, E, F.wave);
            for (int mu = F.vcu; mu < 256; mu += F.G) mini_res<0>(F, YB, D, wl + OW_OUT, XB, XB, (float*)(ws + WS_SSQS_A), 1.0f, nullptr, nullptr, nullptr, mu); }
        SEAM(pb + 4);
        if (IN(pb + 5)) {
            WS_PTRS; pg8::Gemm g{XB, wl + OW_GU2, MPR, 2 * FF, D}; pg8::StaticOrder S; S.init(MPR, 2 * FF, F.G, F.bid); EpiGU E{HB, SSQ};
            stage_rs<6>(F, SSQ, S);
            pg8::gemm_phase<EpiGU, pg8::StaticOrder, true, true>(F.lds, g, S, E, F.wave);
            MINI_GU(XB, wl + OW_GU2, (const float*)(ws + WS_SSQS_A)); }
        SEAM(pb + 5);
        if (IN(pb + 6)) {
            WS_PTRS; pg8::Gemm g{HB, wl + OW_D2, MPR, D, FF}; pg8::StaticOrder S; S.init(MPR, D, F.G, F.bid);
            EpiRes<0> E{XB, XB, SSQ, nullptr, nullptr, 0.5f};
            pg8::gemm_phase<EpiRes<0>, pg8::StaticOrder, true, true>(F.lds, g, S, E, F.wave);
            for (int mu = F.vcu; mu < 256; mu += F.G) mini_res<0>(F, HB, FF, wl + OW_D2, XB, XB, (float*)(ws + WS_SSQS_A), 0.5f, nullptr, nullptr, nullptr, mu); }
        SEAM(pb + 6);
        if (IN(pb + 7)) {
            { WS_PTRS; pg8::Gemm g{(bf16_t*)(ws + WS_PB) + (size_t)l * MP * PLE, wl + OW_PP, MPR, D, PLE}; pg8::StaticOrder S; S.init(MPR, D, F.G, F.bid); EpiBf E{(bf16_t*)(ws + WS_HZ)};
              pg8::gemm_phase<EpiBf, pg8::StaticOrder, true, true>(F.lds, g, S, E, F.wave); }
            { WS_PTRS; pg8::Gemm g{XB, wl + OW_PG, MPR, D, D}; pg8::StaticOrder S; S.init(MPR, D, F.G, F.bid);
              EpiRes<1> E{XB, YB, (float*)(ws + WS_SSQ2), SSQ, (const bf16_t*)(ws + WS_HZ), 1.0f};
              stage_rs<1>(F, SSQ, S);
              pg8::gemm_phase<EpiRes<1>, pg8::StaticOrder, true, true>(F.lds, g, S, E, F.wave);
              for (int mu = F.vcu; mu < 256; mu += F.G) mini_res<1>(F, XB, D, wl + OW_PG, XB, YB, (float*)(ws + WS_SSQS_B), 1.0f, (const float*)(ws + WS_SSQS_A), (bf16_t*)(ws + WS_PB) + (size_t)l * MP * PLE, wl + OW_PP, mu); } }
        SEAM(pb + 7);
    }
#undef IN
#undef SEAM

__global__ void __launch_bounds__(NWAVES * 64, 2) fwd_kernel(Args a_unused) {
    extern __shared__ __attribute__((aligned(16))) unsigned char lds_raw[];
    Frame F;
    F.lds = (LAS unsigned char*)lds_raw;
    F.G = gridDim.x; F.bid = blockIdx.x; F.in = nullptr; F.wave = __builtin_amdgcn_readfirstlane((int)threadIdx.x >> 6);
    F.vcu = (F.G % 8 == 0) ? (F.bid % 8) * (F.G / 8) + F.bid / 8 : F.bid;
    int lo, hi; { const CArgs* ap = kargs(); lo = ap->ph_lo; hi = ap->ph_hi; }
    if (hi - lo > 1) {
        if (threadIdx.x < 2) ((volatile LAS unsigned*)(F.lds + 131072 + 64))[threadIdx.x] = 0u;
        __syncthreads();
        if (threadIdx.x == 0) (void)xb_add(&((unsigned*)(kargs()->ws))[XB_XCNT(xb_xcc_id())], 1u);
    }
#define IN(k) (lo <= (k) && (k) < hi)
#define SEAM(k) do { if (IN(k) && IN((k) + 1)) cg::this_grid().sync(); } while (0)
    if (IN(0)) { p0_prologue(F); }
    SEAM(0);
    layer_phases<0>(F, lo, hi);
    layer_phases<1>(F, lo, hi);
    if (IN(N_PHASES - 1)) {
        const CArgs* ap = kargs(); float* yout = ap->out; const float* SSQ = (const float*)(ap->ws + WS_SSQ2); const float* nf = ap->in[31]; const bf16_t* XF = (const bf16_t*)(ap->ws + WS_Y);
        LOCAL_IDS; const int gw = F.bid * NWAVES + w, NGW = F.G * NWAVES;
        if (gw < MV) {
            int m = gw; u32x2 xq[4]; f32x4 pa; f32x4 gn[4];
#pragma unroll
            for (int j = 0; j < 4; ++j) gn[j] = ((const f32x4*)nf)[lane + 64 * j];
#define F_LOAD(mm) do { pa = (mm) < MPR ? *(const f32x4*)(SSQ + (size_t)(mm) * 16 + (lane & 3) * 4) : *(const f32x4*)((const float*)(ap->ws + WS_SSQS_B) + ((mm) - MPR) * 64 + (lane & 15) * 4); \
            const u32x2* xr_ = (const u32x2*)(XF + (size_t)(mm) * D) + lane; _Pragma("unroll") for (int j = 0; j < 4; ++j) xq[j] = xr_[64 * j]; } while (0)
            f32x4 yv[4];
#define F_COMP(mm) do { float s_ = (pa.x + pa.y) + (pa.z + pa.w); s_ += __shfl_xor(s_, 1); s_ += __shfl_xor(s_, 2); \
            if ((mm) >= MPR) { s_ += __shfl_xor(s_, 4); s_ += __shfl_xor(s_, 8); } \
            const float rs_ = rsqrtf(s_ * (1.f / D) + EPS); \
            _Pragma("unroll") for (int j = 0; j < 4; ++j) yv[j] = unpk4(xq[j]) * rs_ * gn[j]; \
            asm volatile("" : "+v"(yv[0]), "+v"(yv[1]), "+v"(yv[2]), "+v"(yv[3])); } while (0)
            F_LOAD(m); F_COMP(m);
            bool has = m + NGW < MV; if (has) F_LOAD(m + NGW);
            for (;;) {
                f32x4* yo = (f32x4*)(yout + (size_t)m * D) + lane;
#pragma unroll
                for (int j = 0; j < 4; ++j) yo[64 * j] = yv[j];
                if (!has) break;
                m += NGW; F_COMP(m);
                has = m + NGW < MV; if (has) F_LOAD(m + NGW);
            }
#undef F_COMP
#undef F_LOAD
        }
    }
#undef IN
#undef SEAM
#undef WS_PTRS
}

extern "C" void kernel_launch(void* const* d_in, const int* in_sizes, int n_in, void* d_out, int out_size, void* d_ws, size_t ws_size, hipStream_t stream) {
    static int grid = 0;
    if (grid == 0) {
        if (n_in != 32 || (size_t)out_size != OO_END || ws_size < WS_END) { fprintf(stderr, "kernel_launch: unexpected shapes (n_in %d, out %d, ws %zu, need %zu)\n", n_in, out_size, ws_size, (size_t)WS_END); grid = -1; return; }
        int dev = 0, cus = 0, per_cu = 0;
        if (hipGetDevice(&dev) != hipSuccess || hipDeviceGetAttribute(&cus, hipDeviceAttributeMultiprocessorCount, dev) != hipSuccess) { grid = -1; return; }
        if (hipFuncSetAttribute((const void*)fwd_kernel, hipFuncAttributeMaxDynamicSharedMemorySize, LDS_BYTES) != hipSuccess) { fprintf(stderr, "kernel_launch: hipFuncSetAttribute failed\n"); grid = -1; return; }
        if (hipOccupancyMaxActiveBlocksPerMultiprocessor(&per_cu, (const void*)fwd_kernel, NWAVES * 64, LDS_BYTES) != hipSuccess || per_cu < 1) { fprintf(stderr, "kernel_launch: occupancy query says %d\n", per_cu); per_cu = 1; }
        (void)hipGetLastError();
        grid = cus;
    }
    if (grid < 0) return;
    if (hipMemsetAsync(d_ws, 0, 16384, stream) != hipSuccess) { fprintf(stderr, "kernel_launch: memset failed\n"); return; }
    Args a{};
    for (int i = 0; i < 32; ++i) a.in[i] = (const float*)d_in[i];
    a.out = (float*)d_out; a.ws = (unsigned char*)d_ws;
#ifdef PROBE_LIST
    {
        const int plist[] = PROBE_LIST;
        for (unsigned i = 0; i < sizeof(plist) / sizeof(plist[0]); ++i) { a.ph_lo = plist[i]; a.ph_hi = plist[i] + 1; hipLaunchKernelGGL(fwd_kernel, dim3(grid), dim3(NWAVES * 64), LDS_BYTES, stream, a); }
    }
#endif
#if ONE_LAUNCH
    a.ph_lo = 0; a.ph_hi = N_PHASES;
    void* args[] = {&a};
    hipError_t e = hipLaunchCooperativeKernel((const void*)fwd_kernel, dim3(grid), dim3(NWAVES * 64), args, LDS_BYTES, stream);
    if (e != hipSuccess) fprintf(stderr, "cooperative launch failed: %s (grid %d)\n", hipGetErrorString(e), grid);
#else
    for (int p = 0; p < N_PHASES; ++p) {
        a.ph_lo = p; a.ph_hi = p + 1;
        hipLaunchKernelGGL(fwd_kernel, dim3(grid), dim3(NWAVES * 64), LDS_BYTES, stream, a);
    }
#endif
}
```

```cpp
#include <hip/hip_runtime.h>
#include <hip/hip_cooperative_groups.h>
#include <cstdio>
#include <cstdint>
namespace cg = cooperative_groups;

#ifndef ONE_LAUNCH
#define ONE_LAUNCH 1
#endif

namespace pg8 {
#define PG8_LAS __attribute__((address_space(3)))
typedef unsigned short bf16_t;
typedef short bf16x8 __attribute__((ext_vector_type(8)));
typedef float f32x4 __attribute__((ext_vector_type(4)));
typedef unsigned u32x4 __attribute__((ext_vector_type(4)));
typedef unsigned u32x2 __attribute__((ext_vector_type(2)));
constexpr int BM = 256, BK = 64, HALF = 128, HTB = HALF * BK * 2, STAGE_BYTES = 8 * HTB, NXCD = 8, WGM = 8;

__host__ __device__ __forceinline__ int lds_byte(int r, int c) { const int st = (r >> 4) * 2 + (c >> 5), rr = r & 15, cc = c & 31, ob = rr * 64 + cc * 2; return st * 1024 + (ob ^ (((ob >> 9) & 1) << 5)); }
__host__ __device__ __forceinline__ void stage_rc(int b, int& R, int& C) { const int st = b / 1024, sb = b % 1024, swz = sb ^ (((sb >> 9) & 1) << 5); R = (st >> 1) * 16 + swz / 64; C = (st & 1) * 32 + (swz % 64) / 2; }
__host__ __device__ __forceinline__ int perm32(int rho) { const int n = rho >> 4, i = rho & 15; return 8 * (i >> 2) + 4 * n + (i & 3); }

struct Unit { int pm, pn; };
struct Gemm { const bf16_t* A; const bf16_t* Bt; int M, N, K; };

struct StaticOrder {
    int nM, nN, nwg, G, c;
    __host__ __device__ void init(int M, int N, int G_, int c_) { nM = M / BM; nN = N / BM; nwg = nM * nN; G = G_; c = c_; }
    __host__ __device__ bool next(int i, Unit& u) const {
        const long L = (long)i * G + c; if (L >= nwg) return false;
        int wgid = (int)L; { const int q = nwg / NXCD, r = nwg % NXCD, xcd = wgid % NXCD, off = wgid / NXCD; wgid = (xcd < r ? xcd * (q + 1) : r * (q + 1) + (xcd - r) * q) + off; }
        const int nig = WGM * nN, gid = wgid / nig, fm = gid * WGM, gsz = (nM - fm) < WGM ? (nM - fm) : WGM;
        u.pm = fm + ((wgid % nig) % gsz); u.pn = (wgid % nig) / gsz; return true;
    }
    __device__ __forceinline__ void a_ready(const Unit&) const {}
    __device__ __forceinline__ void done(const Unit&) const {}
};

__device__ __forceinline__ unsigned cvt_pk_bf16(float lo, float hi) { unsigned r; asm("v_cvt_pk_bf16_f32 %0, %1, %2" : "=v"(r) : "v"(lo), "v"(hi)); return r; }

template <class Epi, class Sched, bool ALIGN_EPI = false, bool SP2 = false>
__device__ __forceinline__ void gemm_phase(PG8_LAS unsigned char* lds, const Gemm g, const Sched& S, const Epi& E, const int wid) {
    int lane_ = (int)__builtin_amdgcn_mbcnt_hi(~0u, __builtin_amdgcn_mbcnt_lo(~0u, 0u)); asm volatile("" : "+v"(lane_));
    const int lane = lane_, tid = wid * 64 + lane, wr = wid >> 2, wc = wid & 3, fr = lane & 15, fq = lane >> 4;
    const int K = g.K, nt = K / BK;
    unsigned voffA[2], voffB[2];
#pragma unroll
    for (int i = 0; i < 2; ++i) { int R, C; stage_rc(tid * 16 + i * 8192, R, C); const int Rb = Epi::PERM ? ((R & ~31) + perm32(R & 31)) : R;
        voffA[i] = (unsigned)(R * K + C) * 2u; voffB[i] = (unsigned)(Rb * K + C) * 2u; }
    const size_t kstep = (size_t)(BK * 2);
    const size_t hstep = (size_t)HALF * K * 2;
    const size_t tstep = 2 * hstep;
    const unsigned ldsw = (unsigned)wid * 1024u;
    const int aoff = lds_byte(wr * 64 + fr, fq * 8), boff = lds_byte(wc * 32 + fr, fq * 8);
#define PG8_SA(b, h) (((b) * 2 + (h)) * HTB)
#define PG8_SB(b, h) ((4 + (b) * 2 + (h)) * HTB)
#define PG8_STAGE(bufoff, gbase, voff) do { _Pragma("unroll") for (int _i = 0; _i < 2; ++_i) \
        __builtin_amdgcn_global_load_lds((const unsigned*)((const char*)(gbase) + (voff)[_i]), (PG8_LAS unsigned*)(lds + (bufoff) + ldsw + _i * 8192), 16, 0, 0); } while (0)
#define PG8_LDA(dst, b, h) do { _Pragma("unroll") for (int m = 0; m < 4; ++m) _Pragma("unroll") for (int k = 0; k < 2; ++k) dst[m][k] = *(const PG8_LAS bf16x8*)(lds + PG8_SA(b, h) + aoff + m * 2048 + k * 1024); } while (0)
#define PG8_LDB(dst, b, h) do { _Pragma("unroll") for (int n = 0; n < 2; ++n) _Pragma("unroll") for (int k = 0; k < 2; ++k) dst[n][k] = *(const PG8_LAS bf16x8*)(lds + PG8_SB(b, h) + boff + n * 2048 + k * 1024); } while (0)
#define PG8_MMA(ai, bj, At, Bt) do { __builtin_amdgcn_s_setprio(1); _Pragma("unroll") for (int m = 0; m < 4; ++m) _Pragma("unroll") for (int n = 0; n < 2; ++n) _Pragma("unroll") for (int k = 0; k < 2; ++k) \
        acc[ai][bj][m][n] = __builtin_amdgcn_mfma_f32_16x16x32_bf16(Bt[n][k], At[m][k], acc[ai][bj][m][n], 0, 0, 0); __builtin_amdgcn_s_setprio(0); } while (0)
#define PG8_WAIT_V(n) asm volatile("s_waitcnt vmcnt(" #n ")" ::: "memory")
#define PG8_WAIT_L(n) asm volatile("s_waitcnt lgkmcnt(" #n ")" ::: "memory")
#define PG8_BAR __builtin_amdgcn_s_barrier()
#define PG8_SCHED __builtin_amdgcn_sched_barrier(0)
    Unit cur, nxt; int ui = 0;
    if (!S.next(0, cur)) return;
    f32x4 acc[2][2][4][2];
#pragma unroll
    for (int a = 0; a < 2; ++a)
#pragma unroll
        for (int b = 0; b < 2; ++b)
#pragma unroll
            for (int m = 0; m < 4; ++m)
#pragma unroll
                for (int n = 0; n < 2; ++n) acc[a][b][m][n] = (f32x4){0.f, 0.f, 0.f, 0.f};
    bf16x8 At[4][2], B0[2][2], B1[2][2];
    const char* cA = (const char*)g.A + (size_t)cur.pm * tstep; const char* cB = (const char*)g.Bt + (size_t)cur.pn * tstep;
    S.a_ready(cur);
    if constexpr (SP2) {
        PG8_STAGE(PG8_SB(0, 0), cB, voffB); PG8_STAGE(PG8_SB(0, 1), cB + hstep, voffB); PG8_STAGE(PG8_SA(0, 0), cA, voffA); PG8_STAGE(PG8_SA(0, 1), cA + hstep, voffA);
        if (wr == 1) PG8_BAR;
        PG8_WAIT_V(2); PG8_BAR;
        PG8_STAGE(PG8_SB(1, 0), cB + kstep, voffB); PG8_STAGE(PG8_SA(1, 0), cA + kstep, voffA); PG8_STAGE(PG8_SB(1, 1), cB + hstep + kstep, voffB);
        PG8_WAIT_V(6); PG8_BAR;
    } else {
        PG8_STAGE(PG8_SB(0, 0), cB, voffB); PG8_STAGE(PG8_SA(0, 0), cA, voffA); PG8_STAGE(PG8_SB(0, 1), cB + hstep, voffB); PG8_STAGE(PG8_SA(0, 1), cA + hstep, voffA);
        if (wr == 1) PG8_BAR;
        PG8_WAIT_V(4); PG8_BAR;
        PG8_STAGE(PG8_SB(1, 0), cB + kstep, voffB); PG8_STAGE(PG8_SA(1, 0), cA + kstep, voffA); PG8_STAGE(PG8_SB(1, 1), cB + hstep + kstep, voffB);
        PG8_WAIT_V(6); PG8_BAR;
    }
    for (;;) {
        const bool has_next = S.next(ui + 1, nxt);
        const char* nA = has_next ? (const char*)g.A + (size_t)nxt.pm * tstep : cA; const char* nB = has_next ? (const char*)g.Bt + (size_t)nxt.pn * tstep : cB;
        for (int t = 0; t < nt; t += 2) {
            const bool last = (t == nt - 2);
            const char* a1 = cA + (size_t)(t + 1) * kstep;
            const char* a2 = last ? nA : cA + (size_t)(t + 2) * kstep; const char* b2 = last ? nB : cB + (size_t)(t + 2) * kstep;
            const char* a3 = a2 + kstep; const char* b3 = b2 + kstep;
            if (last && has_next) S.a_ready(nxt);
            if constexpr (SP2) {
            PG8_LDB(B0, 0, 0); PG8_LDB(B1, 0, 1); PG8_SCHED; PG8_LDA(At, 0, 0); PG8_STAGE(PG8_SA(1, 1), a1 + hstep, voffA);
            PG8_WAIT_V(8); PG8_WAIT_L(0); PG8_BAR; PG8_MMA(0, 0, At, B0); PG8_MMA(0, 1, At, B1); PG8_BAR; PG8_SCHED;
            PG8_LDA(At, 0, 1); PG8_STAGE(PG8_SB(0, 0), b2, voffB); PG8_STAGE(PG8_SB(0, 1), b2 + hstep, voffB); PG8_STAGE(PG8_SA(0, 0), a2, voffA);
            PG8_WAIT_V(8); PG8_WAIT_L(0); PG8_BAR; PG8_MMA(1, 0, At, B0); PG8_MMA(1, 1, At, B1); PG8_BAR; PG8_SCHED;
            PG8_LDB(B0, 1, 0); PG8_LDB(B1, 1, 1); PG8_SCHED; PG8_LDA(At, 1, 0); PG8_STAGE(PG8_SA(0, 1), a2 + hstep, voffA);
            PG8_WAIT_V(8); PG8_WAIT_L(0); PG8_BAR; PG8_MMA(0, 0, At, B0); PG8_MMA(0, 1, At, B1); PG8_BAR; PG8_SCHED;
            PG8_LDA(At, 1, 1); PG8_STAGE(PG8_SB(1, 0), b3, voffB); PG8_STAGE(PG8_SB(1, 1), b3 + hstep, voffB); PG8_STAGE(PG8_SA(1, 0), a3, voffA);
            PG8_WAIT_V(8); PG8_WAIT_L(0); PG8_BAR; PG8_MMA(1, 0, At, B0); PG8_MMA(1, 1, At, B1); PG8_BAR; PG8_SCHED;
            } else {
            PG8_LDB(B0, 0, 0); PG8_SCHED; PG8_LDA(At, 0, 0); PG8_STAGE(PG8_SA(1, 1), a1 + hstep, voffA);
            PG8_WAIT_L(8); PG8_BAR; PG8_WAIT_L(0); PG8_MMA(0, 0, At, B0); PG8_BAR; PG8_SCHED;
            PG8_LDB(B1, 0, 1); PG8_STAGE(PG8_SB(0, 0), b2, voffB);
            PG8_BAR; PG8_WAIT_L(0); PG8_MMA(0, 1, At, B1); PG8_BAR;
            PG8_LDA(At, 0, 1); PG8_STAGE(PG8_SA(0, 0), a2, voffA);
            PG8_BAR; PG8_WAIT_L(0); PG8_MMA(1, 0, At, B0); PG8_BAR; PG8_SCHED;
            PG8_STAGE(PG8_SB(0, 1), b2 + hstep, voffB);
            PG8_WAIT_V(6); PG8_BAR; PG8_MMA(1, 1, At, B1); PG8_BAR;
            PG8_LDB(B0, 1, 0); PG8_SCHED; PG8_LDA(At, 1, 0); PG8_STAGE(PG8_SA(0, 1), a2 + hstep, voffA);
            PG8_WAIT_L(8); PG8_BAR; PG8_WAIT_L(0); PG8_MMA(0, 0, At, B0); PG8_BAR; PG8_SCHED;
            PG8_LDB(B1, 1, 1); PG8_STAGE(PG8_SB(1, 0), b3, voffB);
            PG8_BAR; PG8_WAIT_L(0); PG8_MMA(0, 1, At, B1); PG8_BAR;
            PG8_LDA(At, 1, 1); PG8_STAGE(PG8_SA(1, 0), a3, voffA);
            PG8_BAR; PG8_WAIT_L(0); PG8_MMA(1, 0, At, B0); PG8_BAR; PG8_SCHED;
            PG8_STAGE(PG8_SB(1, 1), b3 + hstep, voffB);
            PG8_WAIT_V(6); PG8_BAR; PG8_MMA(1, 1, At, B1); PG8_BAR;
            }
        }
        if constexpr (ALIGN_EPI) { if (wr == 0) PG8_BAR; }
        E(acc, cur, (const PG8_LAS float*)(lds + (131072 + 1024)) + ui * 256, wr, wc, fr, fq); S.done(cur);
        if (!has_next) break;
#pragma unroll
        for (int a = 0; a < 2; ++a)
#pragma unroll
            for (int b = 0; b < 2; ++b)
#pragma unroll
                for (int m = 0; m < 4; ++m)
#pragma unroll
                    for (int n = 0; n < 2; ++n) acc[a][b][m][n] = (f32x4){0.f, 0.f, 0.f, 0.f};
        cur = nxt; cA = nA; cB = nB; ++ui;
        if constexpr (ALIGN_EPI) { if (wr == 1) PG8_BAR; }
    }
    PG8_WAIT_V(0);
    if constexpr (!ALIGN_EPI) { if (wr == 0) PG8_BAR; }
    PG8_BAR;
#undef PG8_SA
#undef PG8_SB
#undef PG8_STAGE
#undef PG8_LDA
#undef PG8_LDB
#undef PG8_MMA
#undef PG8_WAIT_V
#undef PG8_WAIT_L
#undef PG8_BAR
#undef PG8_SCHED
}
}

using pg8::bf16_t; using pg8::bf16x8; using pg8::f32x4; using pg8::u32x4; using pg8::u32x2; using pg8::cvt_pk_bf16;
#define LAS __attribute__((address_space(3)))
constexpr int NWAVES = 8;
constexpr int D = 1024, FF = 2816, WA = 512, WB = 512, PLE = 256, INW = 2048, DEPTH = 2;
constexpr int NB = 8, SEQ = 2048, MPR = NB * SEQ  , MS = 128  , MV = MPR + MS  , MP = 16640  ;
constexpr float EPS = 1e-6f;
constexpr size_t OW_GU1 = 0, OW_D1 = OW_GU1 + (size_t)2 * FF * D, OW_IN = OW_D1 + (size_t)D * FF, OW_OUT = OW_IN + (size_t)INW * D, OW_GU2 = OW_OUT + (size_t)D * D,
                 OW_D2 = OW_GU2 + (size_t)2 * FF * D, OW_PG = OW_D2 + (size_t)D * FF, OW_PP = OW_PG + (size_t)D * D, LW = OW_PP + (size_t)D * PLE;
constexpr size_t al256(size_t x) { return (x + 255) & ~(size_t)255; }
constexpr size_t WS_W = 1u << 20;
constexpr size_t WS_XB = al256(WS_W + 2 * LW * 2);
constexpr size_t WS_HZ = al256(WS_XB + (size_t)MP * D * 2);
constexpr size_t HZ_BYTES = (size_t)MP * FF * 2;
constexpr size_t WS_Y = al256(WS_HZ + HZ_BYTES);
constexpr size_t WS_PB = al256(WS_Y + (size_t)MP * D * 2);
constexpr size_t WS_SSQ = al256(WS_PB + (size_t)2 * MP * PLE * 2);
constexpr size_t WS_VST = al256(WS_SSQ + (size_t)MP * 16 * 4);
constexpr size_t WS_SSQ2 = al256(WS_VST + (size_t)MP * 16 * 4);
constexpr size_t WS_SSQS_A = al256(WS_SSQ2 + (size_t)MP * 16 * 4);
constexpr size_t WS_SSQS_B = WS_SSQS_A + 128 * 64 * 4;
constexpr size_t WS_VSTS = WS_SSQS_B + 128 * 64 * 4;
constexpr size_t WS_END = al256(WS_VSTS + 128 * 64 * 4);
static_assert((size_t)MP * 512 * 4 * 2 <= HZ_BYTES && (size_t)MP * D * 4 <= HZ_BYTES, "overlay");
constexpr size_t OO_YS = (size_t)MPR * D, OO_HP = OO_YS + (size_t)MS * D, OO_CP = OO_HP + (size_t)DEPTH * NB * WB, OO_HS = OO_CP + (size_t)DEPTH * NB * 3 * WB,
                 OO_CS = OO_HS + (size_t)DEPTH * MS * WB, OO_CV = OO_CS + (size_t)DEPTH * MS * 3 * WB, OO_END = OO_CV + (size_t)DEPTH * MS * WA;
constexpr int LDS_BYTES = 147456;

__device__ __forceinline__ float fsig(float x) { return __builtin_amdgcn_rcpf(1.f + __expf(-x)); }
__device__ __forceinline__ float fsilu(float x) { return x * fsig(x); }
__device__ __forceinline__ float fgelu(float x) { return x * fsig(1.5957691216f * (x + 0.044715f * x * x * x)); }
__device__ __forceinline__ float bf2f(unsigned short h) { return __builtin_bit_cast(float, (unsigned)h << 16); }
__device__ __forceinline__ unsigned short f2bf(float f) { return (unsigned short)(cvt_pk_bf16(f, 0.f) & 0xffffu); }
__device__ __forceinline__ float wave_sum(float v) {
#pragma unroll
    for (int o = 1; o < 64; o <<= 1) v += __shfl_xor(v, o);
    return v;
}
#define RS_LDS_OFF (131072 + 1024)
__device__ __forceinline__ float row_rstd(const float* ssq, int row, int fq) {
    const f32x4 a = *(const f32x4*)(ssq + (size_t)row * 16 + fq * 4);
    float s = (a.x + a.y) + (a.z + a.w);
    s += __shfl_xor(s, 16); s += __shfl_xor(s, 32);
    return rsqrtf(s * (1.f / D) + EPS);
}

struct EpiGU {
    static constexpr bool PERM = true;
    bf16_t* H; const float* ssq;
    __device__ __forceinline__ void operator()(const f32x4 (&acc)[2][2][4][2], const pg8::Unit& u, const LAS float* rsu, int wr, int wc, int fr, int fq) const {
        const int row0 = u.pm * 256 + wr * 64 + fr, col0 = u.pn * 128 + wc * 32 + 8 * fq;
#pragma unroll
        for (int ai = 0; ai < 2; ++ai)
#pragma unroll
            for (int m = 0; m < 4; ++m) {
                const int r = row0 + ai * 128 + m * 16; const float rs = rsu[ai * 128 + wr * 64 + m * 16 + fr];
                const f32x4 g0 = acc[ai][0][m][0] * rs, g1 = acc[ai][0][m][1] * rs, u0 = acc[ai][1][m][0] * rs, u1 = acc[ai][1][m][1] * rs;
                u32x4 w;
                w.x = cvt_pk_bf16(fsilu(g0[0]) * u0[0], fsilu(g0[1]) * u0[1]); w.y = cvt_pk_bf16(fsilu(g0[2]) * u0[2], fsilu(g0[3]) * u0[3]);
                w.z = cvt_pk_bf16(fsilu(g1[0]) * u1[0], fsilu(g1[1]) * u1[1]); w.w = cvt_pk_bf16(fsilu(g1[2]) * u1[2], fsilu(g1[3]) * u1[3]);
                *(u32x4*)(H + (size_t)r * FF + col0) = w;
            }
    }
};
__device__ __forceinline__ f32x4 unpk4(u32x2 w) { return (f32x4){__builtin_bit_cast(float, w.x << 16), __builtin_bit_cast(float, w.x & 0xffff0000u), __builtin_bit_cast(float, w.y << 16), __builtin_bit_cast(float, w.y & 0xffff0000u)}; }
template <int MODE> struct EpiRes {
    static constexpr bool PERM = true;
    const bf16_t* xin; bf16_t* xout; float* ssq_out; const float* ssq_in; const bf16_t* pp; float scale;
    __device__ __forceinline__ void operator()(const f32x4 (&acc)[2][2][4][2], const pg8::Unit& u, const LAS float* rsu, int wr, int wc, int fr, int fq) const {
        const int col0 = u.pn * 256 + wc * 32 + 8 * fq;
#pragma unroll
        for (int ai = 0; ai < 2; ++ai)
#pragma unroll
            for (int m = 0; m < 4; ++m) {
                const int r = u.pm * 256 + ai * 128 + wr * 64 + m * 16 + fr;
                float rs = 1.f; if (MODE == 1) rs = rsu[ai * 128 + wr * 64 + m * 16 + fr];
                float q = 0.f;
#pragma unroll
                for (int bj = 0; bj < 2; ++bj) {
                    const size_t off = (size_t)r * D + col0 + bj * 128;
                    const u32x4 bw = *(const u32x4*)(xin + off);
                    const f32x4 b0 = unpk4((u32x2){bw.x, bw.y}), b1 = unpk4((u32x2){bw.z, bw.w});
                    f32x4 o0, o1;
                    if (MODE == 0) { o0 = b0 + acc[ai][bj][m][0] * scale; o1 = b1 + acc[ai][bj][m][1] * scale; }
                    else { const u32x4 pw = *(const u32x4*)(pp + off); const f32x4 p0 = unpk4((u32x2){pw.x, pw.y}), p1 = unpk4((u32x2){pw.z, pw.w});
                           const f32x4 z0 = acc[ai][bj][m][0] * rs, z1 = acc[ai][bj][m][1] * rs;
                           o0 = b0 + (f32x4){fsig(z0[0]), fsig(z0[1]), fsig(z0[2]), fsig(z0[3])} * p0; o1 = b1 + (f32x4){fsig(z1[0]), fsig(z1[1]), fsig(z1[2]), fsig(z1[3])} * p1; }
                    u32x4 w; w.x = cvt_pk_bf16(o0[0], o0[1]); w.y = cvt_pk_bf16(o0[2], o0[3]); w.z = cvt_pk_bf16(o1[0], o1[1]); w.w = cvt_pk_bf16(o1[2], o1[3]);
                    *(u32x4*)(xout + off) = w;
                    const f32x4 r0 = unpk4((u32x2){w.x, w.y}), r1 = unpk4((u32x2){w.z, w.w});
                    q += ((r0[0] * r0[0] + r0[1] * r0[1]) + (r0[2] * r0[2] + r0[3] * r0[3])) + ((r1[0] * r1[0] + r1[1] * r1[1]) + (r1[2] * r1[2] + r1[3] * r1[3]));
                }
                q += __shfl_xor(q, 16); q += __shfl_xor(q, 32);
                if (fq == 0) ssq_out[(size_t)r * 16 + u.pn * 4 + wc] = q;
            }
    }
};
struct EpiWin {
    static constexpr bool PERM = true;
    bf16_t* Y; float* V; float* XR; float* vst; const float* ssq;
    __device__ __forceinline__ void operator()(const f32x4 (&acc)[2][2][4][2], const pg8::Unit& u, const LAS float* rsu, int wr, int wc, int fr, int fq) const {
        const int sec = u.pn >> 1, cb = (u.pn & 1) * 256 + wc * 32 + 8 * fq;
#pragma unroll
        for (int ai = 0; ai < 2; ++ai)
#pragma unroll
            for (int m = 0; m < 4; ++m) {
                const int r = u.pm * 256 + ai * 128 + wr * 64 + m * 16 + fr; const float rs = rsu[ai * 128 + wr * 64 + m * 16 + fr];
                float s1 = 0.f, s2 = 0.f;
#pragma unroll
                for (int bj = 0; bj < 2; ++bj) {
                    const int c = cb + bj * 128; const f32x4 z0 = acc[ai][bj][m][0] * rs, z1 = acc[ai][bj][m][1] * rs;
                    if (sec == 2) { *(f32x4*)(XR + (size_t)r * WB + c) = z0; *(f32x4*)(XR + (size_t)r * WB + c + 4) = z1; }
                    else {
                        const f32x4 g0 = (f32x4){fgelu(z0[0]), fgelu(z0[1]), fgelu(z0[2]), fgelu(z0[3])}, g1 = (f32x4){fgelu(z1[0]), fgelu(z1[1]), fgelu(z1[2]), fgelu(z1[3])};
                        if (sec == 1) { *(f32x4*)(V + (size_t)r * WA + c) = g0; *(f32x4*)(V + (size_t)r * WA + c + 4) = g1;
                            s1 += ((g0[0] + g0[1]) + (g0[2] + g0[3])) + ((g1[0] + g1[1]) + (g1[2] + g1[3]));
                            s2 += ((g0[0] * g0[0] + g0[1] * g0[1]) + (g0[2] * g0[2] + g0[3] * g0[3])) + ((g1[0] * g1[0] + g1[1] * g1[1]) + (g1[2] * g1[2] + g1[3] * g1[3])); }
                        else { u32x4 w; w.x = cvt_pk_bf16(g0[0], g0[1]); w.y = cvt_pk_bf16(g0[2], g0[3]); w.z = cvt_pk_bf16(g1[0], g1[1]); w.w = cvt_pk_bf16(g1[2], g1[3]);
                            *(u32x4*)(Y + (size_t)r * D + (sec == 3 ? 512 : 0) + c) = w; }
                    }
                }
                if (sec == 1) {
                    s1 += __shfl_xor(s1, 16); s1 += __shfl_xor(s1, 32); s2 += __shfl_xor(s2, 16); s2 += __shfl_xor(s2, 32);
                    if (fq == 0) { float* p = vst + (size_t)r * 16 + ((u.pn & 1) * 4 + wc) * 2; p[0] = s1; p[1] = s2; }
                }
            }
    }
};
struct EpiBf {
    static constexpr bool PERM = true;
    bf16_t* O;
    __device__ __forceinline__ void operator()(const f32x4 (&acc)[2][2][4][2], const pg8::Unit& u, const LAS float* rsu, int wr, int wc, int fr, int fq) const {
        const int col0 = u.pn * 256 + wc * 32 + 8 * fq;
#pragma unroll
        for (int ai = 0; ai < 2; ++ai)
#pragma unroll
            for (int m = 0; m < 4; ++m) {
                const int r = u.pm * 256 + ai * 128 + wr * 64 + m * 16 + fr;
#pragma unroll
                for (int bj = 0; bj < 2; ++bj) { const f32x4 v0 = acc[ai][bj][m][0], v1 = acc[ai][bj][m][1];
                    u32x4 w; w.x = cvt_pk_bf16(v0[0], v0[1]); w.y = cvt_pk_bf16(v0[2], v0[3]); w.z = cvt_pk_bf16(v1[0], v1[1]); w.w = cvt_pk_bf16(v1[2], v1[3]);
                    *(u32x4*)(O + (size_t)r * D + col0 + bj * 128) = w; }
            }
    }
};

struct Frame {
    LAS unsigned char* lds;
    int G, bid, wave, vcu;
    const float* const* in;
};
struct Args { const float* in[32]; float* out; unsigned char* ws; int ph_lo, ph_hi; };
typedef const Args CArgs;
__device__ __forceinline__ const CArgs* kargs() {
#if defined(__HIP_DEVICE_COMPILE__)
    auto p = __builtin_amdgcn_kernarg_segment_ptr(); asm volatile("" : "+s"(p)); return (const CArgs*)p;
#else
    return nullptr;
#endif
}

#define LOCAL_IDS int lane_l = (int)__builtin_amdgcn_mbcnt_hi(~0u, __builtin_amdgcn_mbcnt_lo(~0u, 0u)); asm volatile("" : "+v"(lane_l)); const int lane = lane_l, w = F.wave, tid = w * 64 + lane; (void)tid

#define XB_TMO      128
#define XB_XCNT(j)  (256  + 64 * (j))
#define XB_XSUB(j)  (1280 + 64 * (j))
#define XB_XGEN(j)  (2304 + 64 * (j))
#define XB_TOP      3328
#define XB_TOPGEN   3392
#define XCD_BAR_WORDS 3456
#define XB_SPIN_CAP (1u << 18)
__device__ __forceinline__ unsigned xb_ld(unsigned* p)              { return __hip_atomic_load(p, __ATOMIC_RELAXED, __HIP_MEMORY_SCOPE_AGENT); }
__device__ __forceinline__ unsigned xb_add(unsigned* p, unsigned v) { return __hip_atomic_fetch_add(p, v, __ATOMIC_RELAXED, __HIP_MEMORY_SCOPE_AGENT); }
__device__ __forceinline__ unsigned xb_xcc_id() { return (unsigned)__builtin_amdgcn_s_getreg((3 << 11) | 20) & 0xFu; }
#define XB_SPIN(cond, bar) do { unsigned _sp = 0; while (cond) { __builtin_amdgcn_s_sleep(1); \
    if ((++_sp & 255u) == 0u) { if (xb_ld(&(bar)[XB_TMO])) break; if (_sp > XB_SPIN_CAP) { atomicAdd(&(bar)[XB_TMO], 1u); break; } } } } while (0)
__device__ __forceinline__ void xcd_barrier_complete(unsigned* bar, unsigned x, unsigned G, unsigned& nloc, unsigned& nx) {
    unsigned sum, cnt, mine, sp = 0u;
    for (;;) {
        sum = 0u; cnt = 0u; mine = 0u;
#pragma unroll
        for (unsigned j = 0; j < 16; ++j) { const unsigned c = xb_ld(&bar[XB_XCNT(j)]); sum += c; cnt += (c > 0u) ? 1u : 0u; mine = (j == x) ? c : mine; }
        if (sum == G) break;
        __builtin_amdgcn_s_sleep(1);
        if ((++sp & 255u) == 0u) { if (xb_ld(&bar[XB_TMO])) break; if (sp > XB_SPIN_CAP) { atomicAdd(&bar[XB_TMO], 1u); break; } }
    }
    nloc = mine > 0u ? mine : 1u; nx = cnt > 0u ? cnt : 1u;
}
__device__ __forceinline__ void xcd_barrier(const Frame& F, unsigned* bar) {
    volatile LAS unsigned* st = (volatile LAS unsigned*)(F.lds + 131072 + 64);
    const int lane_b = (int)__builtin_amdgcn_mbcnt_hi(~0u, __builtin_amdgcn_mbcnt_lo(~0u, 0u));
    asm volatile("s_waitcnt vmcnt(0)" ::: "memory");
    __syncthreads();
    if (F.wave == 0 && lane_b == 0) {
        __builtin_amdgcn_s_waitcnt(0);
        const unsigned x = xb_xcc_id();
        unsigned nloc = st[0], nx = st[1];
        if (nloc == 0u) { xcd_barrier_complete(bar, x, (unsigned)F.G, nloc, nx); st[0] = nloc; st[1] = nx; }
        const unsigned old = xb_add(&bar[XB_XSUB(x)], 1u);
        const unsigned gen = old / nloc;
        if (old + 1u == (gen + 1u) * nloc) {
            __builtin_amdgcn_fence(__ATOMIC_RELEASE, "agent");
            asm volatile("s_waitcnt vmcnt(0)" ::: "memory");
            const unsigned og = xb_add(&bar[XB_TOP], 1u);
            const unsigned tg = og / nx;
            if (og + 1u == (tg + 1u) * nx) xb_add(&bar[XB_TOPGEN], 1u);
            else XB_SPIN(xb_ld(&bar[XB_TOPGEN]) == tg, bar);
            __builtin_amdgcn_fence(__ATOMIC_ACQUIRE, "agent");
            xb_add(&bar[XB_XGEN(x)], 1u);
            asm volatile("s_waitcnt vmcnt(0)" ::: "memory");
        } else {
            XB_SPIN(xb_ld(&bar[XB_XGEN(x)]) == gen, bar);
            __builtin_amdgcn_fence(__ATOMIC_ACQUIRE, "agent");
            asm volatile("s_waitcnt vmcnt(0)" ::: "memory");
        }
    }
    __syncthreads();
}
#define LDS_WAIT() asm volatile("s_waitcnt lgkmcnt(0)" ::: "memory")
#define LBAR() do { asm volatile("s_waitcnt lgkmcnt(0)" ::: "memory"); __builtin_amdgcn_s_barrier(); asm volatile("" ::: "memory"); } while (0)

struct TItem { const float* W; const float* gain; bf16_t* WT; int K, N, mode, item; };
__device__ __forceinline__ TItem p0_decode(const Args& a, bf16_t* Wb, int it) {
    constexpr int I_G = (D / 64) * (FF / 32), I_D = (FF / 64) * (D / 32), I_IN = (D / 64) * (INW / 32), I_O = (D / 64) * (D / 32), I_PP = (PLE / 64) * (D / 32);
    constexpr int PER_LAYER = 4 * I_G + 2 * I_D + I_IN + 2 * I_O + I_PP;
    const int l = it / PER_LAYER; int r = it % PER_LAYER; bf16_t* wl = Wb + (size_t)l * LW;
    if (r < I_G) return TItem{a.in[7] + (size_t)l * D * FF, a.in[6] + l * D, wl + OW_GU1, D, FF, 1, r}; r -= I_G;
    if (r < I_G) return TItem{a.in[8] + (size_t)l * D * FF, a.in[6] + l * D, wl + OW_GU1, D, FF, 2, r}; r -= I_G;
    if (r < I_D) return TItem{a.in[9] + (size_t)l * D * FF, nullptr, wl + OW_D1, FF, D, 0, r}; r -= I_D;
    if (r < I_IN) return TItem{a.in[11] + (size_t)l * D * INW, a.in[10] + l * D, wl + OW_IN, D, INW, 0, r}; r -= I_IN;
    if (r < I_O) return TItem{a.in[23] + (size_t)l * D * D, nullptr, wl + OW_OUT, D, D, 0, r}; r -= I_O;
    if (r < I_G) return TItem{a.in[25] + (size_t)l * D * FF, a.in[24] + l * D, wl + OW_GU2, D, FF, 1, r}; r -= I_G;
    if (r < I_G) return TItem{a.in[26] + (size_t)l * D * FF, a.in[24] + l * D, wl + OW_GU2, D, FF, 2, r}; r -= I_G;
    if (r < I_D) return TItem{a.in[27] + (size_t)l * D * FF, nullptr, wl + OW_D2, FF, D, 0, r}; r -= I_D;
    if (r < I_O) return TItem{a.in[29] + (size_t)l * D * D, a.in[28] + l * D, wl + OW_PG, D, D, 0, r}; r -= I_O;
    return TItem{a.in[30] + (size_t)l * PLE * D, nullptr, wl + OW_PP, PLE, D, 0, r};
}
__device__ __forceinline__ void ti_load(const TItem& t, int lane, float (&v)[32], f32x4 (&g)[2]) {
    const int nblk = t.N / 32, kb = t.item / nblk, nb = t.item % nblk, k0 = 64 * kb, n0 = 32 * nb;
    const float* p = t.W + (size_t)(k0 + (lane >> 5)) * t.N + n0 + (lane & 31);
#pragma unroll
    for (int i = 0; i < 32; ++i) v[i] = __builtin_nontemporal_load(p + (size_t)(2 * i) * t.N);
    g[0] = (f32x4){1.f, 1.f, 1.f, 1.f}; g[1] = g[0];
    if (t.gain) { const f32x4* gp = (const f32x4*)(t.gain + k0 + 8 * (lane & 7)); g[0] = gp[0]; g[1] = gp[1]; }
}
__device__ __forceinline__ void ti_lds(LAS float* scr, int lane, const float (&v)[32]) {
#pragma unroll
    for (int i = 0; i < 32; ++i) scr[(2 * i + (lane >> 5)) * 33 + (lane & 31)] = v[i];
}
__device__ __forceinline__ void ti_store(const TItem& t, LAS float* scr, int lane, const f32x4 (&g)[2]) {
    const int nblk = t.N / 32, kb = t.item / nblk, nb = t.item % nblk, k0 = 64 * kb, n0 = 32 * nb;
    const int drow0 = t.mode == 0 ? n0 : (256 * (n0 >> 7) + (n0 & 127) + (t.mode == 2 ? 128 : 0));
    const int c = lane & 7;
    float sv[4][8];
#pragma unroll
    for (int j = 0; j < 4; ++j) { const LAS float* sp = scr + (8 * c) * 33 + (lane >> 3) + 8 * j;
#pragma unroll
        for (int e = 0; e < 8; ++e) sv[j][e] = sp[e * 33]; }
#pragma unroll
    for (int j = 0; j < 4; ++j) { const int n = (lane >> 3) + 8 * j;
        u32x4 o; o.x = cvt_pk_bf16(sv[j][0] * g[0].x, sv[j][1] * g[0].y); o.y = cvt_pk_bf16(sv[j][2] * g[0].z, sv[j][3] * g[0].w);
        o.z = cvt_pk_bf16(sv[j][4] * g[1].x, sv[j][5] * g[1].y); o.w = cvt_pk_bf16(sv[j][6] * g[1].z, sv[j][7] * g[1].w);
        *(u32x4*)(t.WT + (size_t)(drow0 + n) * t.K + k0 + 8 * c) = o; }
}

__device__ __forceinline__ void p0_prologue(const Frame& F) {
    const CArgs* ap = kargs(); const Args& a = *ap;
    LOCAL_IDS;
    LAS float* scr = (LAS float*)(F.lds + w * 16384);
    const int gw = F.bid * NWAVES + w, NGW = F.G * NWAVES;
    bf16_t* Wb = (bf16_t*)(a.ws + WS_W);
    constexpr int I_G = (D / 64) * (FF / 32), I_D = (FF / 64) * (D / 32), I_IN = (D / 64) * (INW / 32), I_O = (D / 64) * (D / 32), I_PP = (PLE / 64) * (D / 32);
    constexpr int NIT = DEPTH * (4 * I_G + 2 * I_D + I_IN + 2 * I_O + I_PP);
    if (gw < NIT) {
        int it = gw; TItem cur = p0_decode(a, Wb, it), nxt = cur; float v[32]; f32x4 g[2], g2[2]; ti_load(cur, lane, v, g);
        ti_lds(scr, lane, v);
        LDS_WAIT(); asm volatile("" ::: "memory");
        bool has = it + NGW < NIT; g2[0] = g[0]; g2[1] = g[1];
        if (has) { nxt = p0_decode(a, Wb, it + NGW); ti_load(nxt, lane, v, g2); }
        for (;;) {
            ti_store(cur, scr, lane, g);
            if (!has) break;
            LDS_WAIT(); asm volatile("" ::: "memory");
            ti_lds(scr, lane, v);
            LDS_WAIT(); asm volatile("" ::: "memory");
            cur = nxt; g[0] = g2[0]; g[1] = g2[1]; it += NGW;
            has = it + NGW < NIT;
            if (has) { nxt = p0_decode(a, Wb, it + NGW); ti_load(nxt, lane, v, g2); }
        }
        LDS_WAIT(); asm volatile("" ::: "memory");
    }
    bf16_t* XB = (bf16_t*)(a.ws + WS_Y); float* SSQ = (float*)(a.ws + WS_SSQ2);
    if (gw < MV) {
        int m = gw; f32x4 v[4]; float sq = 0.f; u32x2 wq[4];
#define X_LOAD(mm) do { const f32x4* xr_ = (const f32x4*)((mm) < MPR ? a.in[0] + (size_t)(mm) * D : a.in[1] + (size_t)((mm) - MPR) * D) + lane; \
        _Pragma("unroll") for (int j = 0; j < 4; ++j) v[j] = xr_[64 * j]; } while (0)
#define X_PACK() do { sq = 0.f; _Pragma("unroll") for (int j = 0; j < 4; ++j) { sq += (v[j].x * v[j].x + v[j].y * v[j].y) + (v[j].z * v[j].z + v[j].w * v[j].w); \
        wq[j].x = cvt_pk_bf16(v[j].x, v[j].y); wq[j].y = cvt_pk_bf16(v[j].z, v[j].w); } \
        asm volatile("" : "+v"(wq[0].x), "+v"(wq[0].y), "+v"(wq[1].x), "+v"(wq[1].y), "+v"(wq[2].x), "+v"(wq[2].y), "+v"(wq[3].x), "+v"(wq[3].y), "+v"(sq)); } while (0)
        X_LOAD(m); X_PACK();
        bool has = m + NGW < MV; if (has) X_LOAD(m + NGW);
        for (;;) {
            const float s = wave_sum(sq);
            u32x2* o8 = (u32x2*)(XB + (size_t)m * D) + lane;
#pragma unroll
            for (int j = 0; j < 4; ++j) o8[64 * j] = wq[j];
            if (m < MPR) { if (lane < 16) SSQ[(size_t)m * 16 + lane] = lane == 0 ? s : 0.f; }
            else ((float*)(a.ws + WS_SSQS_B))[(m - MPR) * 64 + lane] = lane == 0 ? s : 0.f;
            if (!has) break;
            m += NGW; X_PACK();
            has = m + NGW < MV; if (has) X_LOAD(m + NGW);
        }
#undef X_LOAD
#undef X_PACK
    }
    bf16_t* PB = (bf16_t*)(a.ws + WS_PB);
    if (gw < DEPTH * MV) {
        int i = gw; f32x4 v; u32x2 wq;
#define P_LOAD(ii) do { const int l_ = (ii) / MV, m_ = (ii) % MV; v = ((const f32x4*)(m_ < MPR ? a.in[4] + ((size_t)l_ * MPR + m_) * PLE : a.in[5] + ((size_t)l_ * MS + (m_ - MPR)) * PLE))[lane]; } while (0)
#define P_PACK() do { wq.x = cvt_pk_bf16(v.x, v.y); wq.y = cvt_pk_bf16(v.z, v.w); asm volatile("" : "+v"(wq.x), "+v"(wq.y)); } while (0)
        P_LOAD(i); P_PACK();
        bool has = i + NGW < DEPTH * MV; if (has) P_LOAD(i + NGW);
        for (;;) {
            ((u32x2*)(PB + ((size_t)(i / MV) * MP + (i % MV)) * PLE))[lane] = wq;
            if (!has) break;
            i += NGW; P_PACK();
            has = i + NGW < DEPTH * MV; if (has) P_LOAD(i + NGW);
        }
#undef P_LOAD
#undef P_PACK
    }
}

__device__ __forceinline__ void rglru_unit(const Frame& F, int l, int unit) {
    const CArgs* ap = kargs(); const Args& a = *ap;
    const int b = unit >> 5, hb = (unit >> 2) & 7, sub = unit & 3;
    LOCAL_IDS; const int fr = lane & 15, fq = lane >> 4;
    LAS bf16_t* XC = (LAS bf16_t*)F.lds;
    LAS float* XCF = (LAS float*)(F.lds + 18432);
    LAS float* SUM = (LAS float*)(F.lds + 18432 + 8192);
    const float* XR = (const float*)(a.ws + WS_HZ + (size_t)MP * WA * 4);
    bf16_t* Y = (bf16_t*)(a.ws + WS_Y);
    const size_t row0 = (size_t)b * SEQ;
    const int chh = hb * 64, ch = chh + sub * 16 + fr;
    const int c4 = (tid & 15) * 4, tk = tid >> 4;
    f32x4 cw[4];
#pragma unroll
    for (int k = 0; k < 4; ++k) cw[k] = *(const f32x4*)(a.in[16] + ((size_t)l * 4 + k) * WB + chh + c4);
    const f32x4 cbias = *(const f32x4*)(a.in[17] + (size_t)l * WB + chh + c4);
    bf16x8 Br[2], Bi[2];
    {
        const float* wrp = a.in[18] + ((size_t)(l * 8 + hb) * 64) * 64 + sub * 16 + fr;
        const float* wip = a.in[20] + ((size_t)(l * 8 + hb) * 64) * 64 + sub * 16 + fr;
#pragma unroll
        for (int ks = 0; ks < 2; ++ks)
#pragma unroll
            for (int e = 0; e < 8; e += 2) {
                const int i0 = 32 * ks + 8 * fq + e;
                const unsigned pr = cvt_pk_bf16(wrp[(size_t)i0 * 64], wrp[(size_t)(i0 + 1) * 64]), pi = cvt_pk_bf16(wip[(size_t)i0 * 64], wip[(size_t)(i0 + 1) * 64]);
                Br[ks][e] = (short)(pr & 0xffffu); Br[ks][e + 1] = (short)(pr >> 16); Bi[ks][e] = (short)(pi & 0xffffu); Bi[ks][e + 1] = (short)(pi >> 16);
            }
    }
    const float br = a.in[19][l * WB + ch], bi = a.in[21][l * WB + ch];
    const float c8 = -8.f * log1pf(expf(-a.in[22][l * WB + ch]));
    const int tg = tid >> 4;
    f32x4 xr[11];
#define RG_LOAD(it_) do { _Pragma("unroll") for (int i2 = 0; i2 < 11; ++i2) { const int tt = 256 * (it_) + 8 * tg - 3 + i2; \
        xr[i2] = tt >= 0 ? *(const f32x4*)(XR + (row0 + tt) * WB + chh + c4) : (f32x4){0.f, 0.f, 0.f, 0.f}; } } while (0)
    LAS bf16_t* XC2 = (LAS bf16_t*)F.lds;
    LAS float* XCF2 = (LAS float*)(F.lds + 36864);
    LAS float* SUM2 = (LAS float*)(F.lds + 36864 + 16384);
    RG_LOAD(0);
    float hcar = 0.f;
    LBAR();
    for (int it = 0; it < SEQ / 256; ++it) {
#pragma unroll
        for (int j2 = 0; j2 < 8; ++j2) {
            f32x4 xc = cbias;
#pragma unroll
            for (int k = 0; k < 4; ++k) xc += xr[j2 + k] * cw[k];
            const int tok = 8 * tg + j2;
            u32x2 pk; pk.x = cvt_pk_bf16(xc[0], xc[1]); pk.y = cvt_pk_bf16(xc[2], xc[3]);
            *(LAS u32x2*)(XC2 + tok * 72 + c4) = pk;
            if ((c4 >> 4) == sub) *(LAS f32x4*)(XCF2 + tok * 16 + (c4 & 15)) = xc;
        }
        if (it + 1 < SEQ / 256) RG_LOAD(it + 1);
        bf16_t* yp = Y + (row0 + 256 * it + 32 * w + 4 * fq) * D + 512 + ch;
        float gt[2][4];
#pragma unroll
        for (int t2 = 0; t2 < 2; ++t2)
#pragma unroll
            for (int j2 = 0; j2 < 4; ++j2) gt[t2][j2] = bf2f(yp[(size_t)(16 * t2 + j2) * D]);
        LBAR();
        float Pj[2][4], Hj[2][4], Pl[2], Hl[2], Pe[2], He[2];
#pragma unroll
        for (int t2 = 0; t2 < 2; ++t2) {
            const int trow = 32 * w + 16 * t2;
            const bf16x8 a0 = *(const LAS bf16x8*)(XC2 + (trow + fr) * 72 + 8 * fq), a1 = *(const LAS bf16x8*)(XC2 + (trow + fr) * 72 + 32 + 8 * fq);
            f32x4 accr = (f32x4){0.f, 0.f, 0.f, 0.f}, acci = (f32x4){0.f, 0.f, 0.f, 0.f};
            accr = __builtin_amdgcn_mfma_f32_16x16x32_bf16(a0, Br[0], accr, 0, 0, 0); accr = __builtin_amdgcn_mfma_f32_16x16x32_bf16(a1, Br[1], accr, 0, 0, 0);
            acci = __builtin_amdgcn_mfma_f32_16x16x32_bf16(a0, Bi[0], acci, 0, 0, 0); acci = __builtin_amdgcn_mfma_f32_16x16x32_bf16(a1, Bi[1], acci, 0, 0, 0);
#pragma unroll
            for (int j2 = 0; j2 < 4; ++j2) {
                const float xcf = XCF2[(trow + 4 * fq + j2) * 16 + fr];
                const float rg = fsig(accr[j2] + br), ig = fsig(acci[j2] + bi);
                const float la = c8 * rg, av = __expf(la), uv = sqrtf(fmaxf(1.f - __expf(2.f * la), 0.f)) * (ig * xcf);
                if (j2 == 0) { Pj[t2][0] = av; Hj[t2][0] = uv; } else { Pj[t2][j2] = av * Pj[t2][j2 - 1]; Hj[t2][j2] = av * Hj[t2][j2 - 1] + uv; }
            }
            Pl[t2] = Pj[t2][3]; Hl[t2] = Hj[t2][3];
        }
#pragma unroll
        for (int t2 = 0; t2 < 2; ++t2) {
            float Pp = __shfl_up(Pl[t2], 16), Hp = __shfl_up(Hl[t2], 16);
            if (fq >= 1) { Hl[t2] = Pl[t2] * Hp + Hl[t2]; Pl[t2] = Pl[t2] * Pp; }
            Pp = __shfl_up(Pl[t2], 32); Hp = __shfl_up(Hl[t2], 32);
            if (fq >= 2) { Hl[t2] = Pl[t2] * Hp + Hl[t2]; Pl[t2] = Pl[t2] * Pp; }
            Pe[t2] = __shfl_up(Pl[t2], 16); He[t2] = __shfl_up(Hl[t2], 16);
            if (fq == 0) { Pe[t2] = 1.f; He[t2] = 0.f; }
        }
        const float P0t = __shfl(Pl[0], 48 + fr), H0t = __shfl(Hl[0], 48 + fr);
        if (fq == 3) { SUM2[(w * 16 + fr) * 2] = Pl[1] * P0t; SUM2[(w * 16 + fr) * 2 + 1] = Pl[1] * H0t + Hl[1]; }
        LBAR();
        float carry = hcar, cwv = hcar;
#pragma unroll
        for (int w2 = 0; w2 < 8; ++w2) { const float Pw = SUM2[(w2 * 16 + fr) * 2], Hw = SUM2[(w2 * 16 + fr) * 2 + 1]; if (w2 == w) cwv = carry; carry = Pw * carry + Hw; }
        hcar = carry;
        const float c1w = P0t * cwv + H0t;
#pragma unroll
        for (int t2 = 0; t2 < 2; ++t2) {
            const float cl = Pe[t2] * (t2 == 0 ? cwv : c1w) + He[t2];
#pragma unroll
            for (int j2 = 0; j2 < 4; ++j2) { const float h = Pj[t2][j2] * cl + Hj[t2][j2]; yp[(size_t)(16 * t2 + j2) * D] = f2bf(h * gt[t2][j2]); }
        }
    }
#undef RG_LOAD
    if (w == 0 && fq == 0) a.out[OO_HP + ((size_t)l * NB + b) * WB + ch] = hcar;
    if (tid < 48) { const int k = tid >> 4, c = chh + sub * 16 + (tid & 15);
        a.out[OO_CP + (((size_t)l * NB + b) * 3 + k) * WB + c] = XR[(row0 + SEQ - 3 + k) * WB + c]; }
}

__device__ __forceinline__ void gmlp_units(const Frame& F, int l) {
    const CArgs* ap = kargs(); const Args& a = *ap;
    LOCAL_IDS; const int fr = lane & 15, fq = lane >> 4;
    constexpr int NU = NB * 16 * 8;
    int u = F.bid, ustep = F.G, uend = NU;
    if (F.G == 256) { const int x = F.bid & 7, j = F.bid >> 3; u = x * 128 + (j >> 3) * 8 + (j & 7); ustep = 32; uend = x * 128 + 128; }
    if (u >= uend) return;
    LAS bf16_t* VT = (LAS bf16_t*)F.lds;
    const float* V = (const float*)(a.ws + WS_HZ); const float* VST = (const float*)(a.ws + WS_VST);
    bf16_t* Y = (bf16_t*)(a.ws + WS_Y);
    const int irow = 16 * w + fr, tok = tid >> 2, d0 = (tid & 3) * 16;
    int hc = -1; bf16x8 Wf[4]; f32x4 gq[4], bq[4]; float bs = 0.f;
    f32x4 st, vv[4]; u32x2 uv[4], uvc[4];
#define G_CONST(h_) do { hc = (h_); const float* wsp = a.in[14] + (((size_t)l * 8 + hc) * 128 + irow) * 128; \
        _Pragma("unroll") for (int ks = 0; ks < 4; ++ks) { \
            if (ks <= (w >> 1)) { const int j0 = 32 * ks + 8 * fq; const f32x4 w0 = *(const f32x4*)(wsp + j0), w1 = *(const f32x4*)(wsp + j0 + 4); \
                float e[8] = {w0[0], w0[1], w0[2], w0[3], w1[0], w1[1], w1[2], w1[3]}; \
                _Pragma("unroll") for (int q = 0; q < 8; q += 2) { const unsigned pk = cvt_pk_bf16(j0 + q <= irow ? e[q] : 0.f, j0 + q + 1 <= irow ? e[q + 1] : 0.f); Wf[ks][q] = (short)(pk & 0xffffu); Wf[ks][q + 1] = (short)(pk >> 16); } \
            } else { Wf[ks] = (bf16x8){0, 0, 0, 0, 0, 0, 0, 0}; } } \
        _Pragma("unroll") for (int q = 0; q < 4; ++q) { gq[q] = *(const f32x4*)(a.in[12] + (size_t)l * WA + hc * 64 + 16 * q + (d0 >> 2)); bq[q] = *(const f32x4*)(a.in[13] + (size_t)l * WA + hc * 64 + 16 * q + (d0 >> 2)); } \
        bs = a.in[15][((size_t)l * 8 + hc) * 128 + irow]; } while (0)
#define G_LOAD(uu) do { const int h_ = (uu) & 7; const size_t r0_ = (size_t)((uu) >> 3) * 128, row_ = r0_ + tok; \
        st = *(const f32x4*)(VST + row_ * 16 + (tid & 3) * 4); \
        _Pragma("unroll") for (int q = 0; q < 4; ++q) vv[q] = *(const f32x4*)(V + row_ * WA + h_ * 64 + 16 * q + (d0 >> 2)); \
        const bf16_t* yp_ = Y + (r0_ + irow) * D + h_ * 64 + 4 * fq; \
        _Pragma("unroll") for (int nt = 0; nt < 4; ++nt) uv[nt] = *(const u32x2*)(yp_ + 16 * nt); } while (0)
#define G_LN() do { float s1 = st[0] + st[2], s2 = st[1] + st[3]; \
        s1 += __shfl_xor(s1, 1); s1 += __shfl_xor(s1, 2); s2 += __shfl_xor(s2, 1); s2 += __shfl_xor(s2, 2); \
        const float mean = s1 * (1.f / WA), rstd = rsqrtf(fmaxf(s2 * (1.f / WA) - mean * mean, 0.f) + EPS); \
        _Pragma("unroll") for (int q = 0; q < 4; ++q) { const f32x4 o = (vv[q] - mean) * rstd * gq[q] + bq[q]; \
            _Pragma("unroll") for (int e = 0; e < 4; ++e) VT[(16 * q + (d0 >> 2) + e) * 136 + tok] = f2bf(o[e]); } \
        _Pragma("unroll") for (int nt = 0; nt < 4; ++nt) uvc[nt] = uv[nt]; } while (0)
    G_LOAD(u); G_CONST(u & 7);
    LBAR();
    G_LN();
    bool has = u + ustep < uend; if (has) G_LOAD(u + ustep);
    for (;;) {
        LBAR();
        f32x4 acc[4];
#pragma unroll
        for (int nt = 0; nt < 4; ++nt) acc[nt] = (f32x4){0.f, 0.f, 0.f, 0.f};
#pragma unroll
        for (int ks = 0; ks < 4; ++ks) {
            if (ks <= (w >> 1)) {
#pragma unroll
                for (int nt = 0; nt < 4; ++nt) {
                    const bf16x8 av = *(const LAS bf16x8*)(VT + (16 * nt + fr) * 136 + 32 * ks + 8 * fq);
                    acc[nt] = __builtin_amdgcn_mfma_f32_16x16x32_bf16(av, Wf[ks], acc[nt], 0, 0, 0);
                }
            }
        }
        LBAR();
        bf16_t* yp = Y + ((size_t)(u >> 3) * 128 + irow) * D + (u & 7) * 64 + 4 * fq;
#pragma unroll
        for (int nt = 0; nt < 4; ++nt) {
            const float u0 = bf2f((unsigned short)(uvc[nt].x & 0xffffu)), u1 = bf2f((unsigned short)(uvc[nt].x >> 16)), u2 = bf2f((unsigned short)(uvc[nt].y & 0xffffu)), u3 = bf2f((unsigned short)(uvc[nt].y >> 16));
            u32x2 o; o.x = cvt_pk_bf16(u0 * (acc[nt][0] + bs), u1 * (acc[nt][1] + bs)); o.y = cvt_pk_bf16(u2 * (acc[nt][2] + bs), u3 * (acc[nt][3] + bs));
            *(u32x2*)(yp + 16 * nt) = o;
        }
        if (!has) break;
        u += ustep;
        if ((u & 7) != hc) G_CONST(u & 7);
        G_LN();
        has = u + ustep < uend; if (has) G_LOAD(u + ustep);
    }
#undef G_CONST
#undef G_LOAD
#undef G_LN
}

__device__ __forceinline__ float sum16(float s) { s += __shfl_xor(s, 1); s += __shfl_xor(s, 2); s += __shfl_xor(s, 4); s += __shfl_xor(s, 8); return s; }
__device__ __forceinline__ void sample_mix_unit(const Frame& F, int l, int sb) {
    const CArgs* ap = kargs(); const Args& a = *ap;
    LOCAL_IDS; const int c = tid;
    LAS float* xcs = (LAS float*)F.lds;
    const size_t row = (size_t)MPR + sb;
    const float* V = (const float*)(a.ws + WS_HZ); const float* XR = (const float*)(a.ws + WS_HZ + (size_t)MP * WA * 4); const float* VST = (const float*)(a.ws + WS_VSTS);
    bf16_t* Y = (bf16_t*)(a.ws + WS_Y);
    const int h = c >> 6, j = c & 63;
    const f32x4 stp = *(const f32x4*)(VST + sb * 64 + (c & 15) * 4);
    const float vraw = V[row * WA + c], lng = a.in[12][l * WA + c], lnb = a.in[13][l * WA + c];
    const float ws00 = a.in[14][((size_t)l * 8 + h) * 128 * 128], bs0 = a.in[15][((size_t)l * 8 + h) * 128];
    const float yu = bf2f(Y[row * D + c]), yg = bf2f(Y[row * D + 512 + c]);
    const float xr = XR[row * WB + c];
    const float* sc = a.in[3] + ((size_t)l * MS + sb) * 3 * WB;
    const float b0 = sc[c], b1 = sc[WB + c], b2 = sc[2 * WB + c];
    const float* cwp = a.in[16] + (size_t)l * 4 * WB;
    const float cw0 = cwp[c], cw1 = cwp[WB + c], cw2 = cwp[2 * WB + c], cw3 = cwp[3 * WB + c], cbv = a.in[17][l * WB + c];
    const float brv = a.in[19][l * WB + c], biv = a.in[21][l * WB + c], lamv = a.in[22][l * WB + c], h0 = a.in[2][((size_t)l * MS + sb) * WB + c];
    const float* wrp = a.in[18] + ((size_t)(l * 8 + h) * 64) * 64 + j; const float* wip = a.in[20] + ((size_t)(l * 8 + h) * 64) * 64 + j;
    float wrv[64], wiv[64];
#pragma unroll
    for (int i = 0; i < 64; ++i) { wrv[i] = wrp[(size_t)i * 64]; wiv[i] = wip[(size_t)i * 64]; }
    const float s1 = sum16(stp.x + stp.z), s2 = sum16(stp.y + stp.w);
    const float mean = s1 * (1.f / WA), rstd = rsqrtf(fmaxf(s2 * (1.f / WA) - mean * mean, 0.f) + EPS);
    const float vln = (vraw - mean) * rstd * lng + lnb;
    const float sg = ws00 * vln + bs0;
    const float xc = cbv + b0 * cw0 + b1 * cw1 + b2 * cw2 + xr * cw3;
    LBAR();
    xcs[c] = xc;
    LBAR();
    float ar = brv, ai = biv;
#pragma unroll
    for (int i = 0; i < 64; ++i) { const float x = xcs[h * 64 + i]; ar += x * wrv[i]; ai += x * wiv[i]; }
    const float rg = fsig(ar), ig = fsig(ai);
    const float la = -8.f * log1pf(expf(-lamv)) * rg;
    const float av = __expf(la), uv = sqrtf(fmaxf(1.f - __expf(2.f * la), 0.f)) * (ig * xc);
    const float hn = av * h0 + uv;
    a.out[OO_CV + ((size_t)l * MS + sb) * WA + c] = vln;
    Y[row * D + c] = f2bf(yu * sg);
    a.out[OO_HS + ((size_t)l * MS + sb) * WB + c] = hn;
    float* co = a.out + OO_CS + ((size_t)l * MS + sb) * 3 * WB;
    co[c] = b1; co[WB + c] = b2; co[2 * WB + c] = xr;
    Y[row * D + 512 + c] = f2bf(hn * yg);
}

constexpr int N_PHASES = 2 + 8 * DEPTH;


template <int NBM, int BATCH = (NBM == 1 ? 12 : 6)>
__device__ __forceinline__ void mini_core(LAS unsigned char* lds, const bf16_t* Arow, int lda, const bf16_t* B0, const bf16_t* B1, int K, int w, int lane, float& v0, float& v1) {
    const int fr = lane & 15, fq = lane >> 4;
    const int Kw = K >> 3, nsteps = Kw >> 5, k0 = w * Kw + 8 * fq;
    const bf16_t* pa0 = Arow + (size_t)fr * lda + k0; const bf16_t* pa1 = pa0 + (size_t)16 * lda;
    const bf16_t* pb0 = B0 + (size_t)fr * K + k0; const bf16_t* pb1 = B1 + (size_t)fr * K + k0;
    f32x4 acc00 = (f32x4){0.f, 0.f, 0.f, 0.f}, acc01 = acc00, acc10 = acc00, acc11 = acc00;
    for (int s0 = 0; s0 < nsteps; s0 += BATCH) {
        bf16x8 a0[BATCH], a1[BATCH], b0[BATCH], b1[BATCH];
#pragma unroll
        for (int i = 0; i < BATCH; ++i) if (s0 + i < nsteps) { const int ko = (s0 + i) * 32;
            a0[i] = *(const bf16x8*)(pa0 + ko); a1[i] = *(const bf16x8*)(pa1 + ko); b0[i] = *(const bf16x8*)(pb0 + ko); if (NBM == 2) b1[i] = *(const bf16x8*)(pb1 + ko); }
#pragma unroll
        for (int i = 0; i < BATCH; ++i) if (s0 + i < nsteps) {
            acc00 = __builtin_amdgcn_mfma_f32_16x16x32_bf16(b0[i], a0[i], acc00, 0, 0, 0); acc01 = __builtin_amdgcn_mfma_f32_16x16x32_bf16(b0[i], a1[i], acc01, 0, 0, 0);
            if (NBM == 2) { acc10 = __builtin_amdgcn_mfma_f32_16x16x32_bf16(b1[i], a0[i], acc10, 0, 0, 0); acc11 = __builtin_amdgcn_mfma_f32_16x16x32_bf16(b1[i], a1[i], acc11, 0, 0, 0); } }
    }
    LAS float* P = (LAS float*)lds;
    *(LAS f32x4*)(P + ((0 * 8 + w) * 32 + fr) * 16 + 4 * fq) = acc00; *(LAS f32x4*)(P + ((0 * 8 + w) * 32 + 16 + fr) * 16 + 4 * fq) = acc01;
    if (NBM == 2) { *(LAS f32x4*)(P + ((8 + w) * 32 + fr) * 16 + 4 * fq) = acc10; *(LAS f32x4*)(P + ((8 + w) * 32 + 16 + fr) * 16 + 4 * fq) = acc11; }
    LBAR();
    const int t = w * 64 + lane; float s0_ = 0.f, s1_ = 0.f;
#pragma unroll
    for (int w2 = 0; w2 < 8; ++w2) { s0_ += P[w2 * 512 + t]; if (NBM == 2) s1_ += P[(8 + w2) * 512 + t]; }
    v0 = s0_; v1 = s1_;
    LBAR();
}
__device__ __forceinline__ float srow_rstd(const float* ssqs, int srow, int col) {
    const f32x4 a = *(const f32x4*)(ssqs + srow * 64 + col * 4); float s = (a.x + a.y) + (a.z + a.w);
    s += __shfl_xor(s, 1); s += __shfl_xor(s, 2); s += __shfl_xor(s, 4); s += __shfl_xor(s, 8);
    return rsqrtf(s * (1.f / D) + EPS);
}

__device__ __forceinline__ void mini_gu(const Frame& F, const bf16_t* Ain, const bf16_t* Wgu, const float* ssqs, bf16_t* H, int mu) {
    LOCAL_IDS; const int rg = mu & 3, c0 = (mu >> 2) * 16, row = tid >> 4, col = tid & 15;
    const bf16_t* B0 = Wgu + (size_t)(256 * (c0 >> 7) + (c0 & 127)) * D;
    const float rs = srow_rstd(ssqs, 32 * rg + row, col);
    float g, u; mini_core<2>(F.lds, Ain + (size_t)(MPR + 32 * rg) * D, D, B0, B0 + (size_t)128 * D, D, w, lane, g, u);
    H[(size_t)(MPR + 32 * rg + row) * FF + c0 + col] = f2bf(fsilu(g * rs) * (u * rs));
}
template <int MODE>
__device__ __forceinline__ void mini_res(const Frame& F, const bf16_t* Ain, int K, const bf16_t* W, const bf16_t* xin, bf16_t* xout, float* ssqs_out, float scale,
                                         const float* ssqs_in, const bf16_t* Pin, const bf16_t* Wp, int mu) {
    LOCAL_IDS; const int rg = mu & 3, cg = mu >> 2, c0 = cg * 16, row = tid >> 4, col = tid & 15;
    const size_t off = (size_t)(MPR + 32 * rg + row) * D + c0 + col;
    const float xb0 = bf2f(xin[off]); float rs = 1.f; if (MODE == 1) rs = srow_rstd(ssqs_in, 32 * rg + row, col);
    float v, dummy; mini_core<1>(F.lds, Ain + (size_t)(MPR + 32 * rg) * K, K, W + (size_t)c0 * K, W + (size_t)c0 * K, K, w, lane, v, dummy);
    float o;
    if (MODE == 0) o = xb0 + scale * v;
    else { float pv; mini_core<1>(F.lds, Pin + (size_t)(MPR + 32 * rg) * PLE, PLE, Wp + (size_t)c0 * PLE, Wp + (size_t)c0 * PLE, PLE, w, lane, pv, dummy);
           o = xb0 + fsig(v * rs) * pv; }
    const unsigned short ob = f2bf(o); xout[off] = ob;
    const float orr = bf2f(ob), q = sum16(orr * orr);
    if (col == 0) ssqs_out[(32 * rg + row) * 64 + cg] = q;
}
__device__ __forceinline__ void mini_win(const Frame& F, const bf16_t* Ain, const bf16_t* W, const float* ssqs, bf16_t* Y, float* V, float* XR, float* vsts, int mu) {
    LOCAL_IDS; const int rg = mu & 3, cg = mu >> 2, c0 = cg * 16, row = tid >> 4, col = tid & 15;
    const float rsw = srow_rstd(ssqs, 32 * rg + row, col);
    float v, dummy; mini_core<1>(F.lds, Ain + (size_t)(MPR + 32 * rg) * D, D, W + (size_t)c0 * D, W + (size_t)c0 * D, D, w, lane, v, dummy);
    const float z = v * rsw;
    const int sec = c0 >> 9, cc = (c0 & 511) + col; const size_t r = (size_t)MPR + 32 * rg + row;
    if (sec == 2) XR[r * WB + cc] = z;
    else { const float gz = fgelu(z);
        if (sec == 0) Y[r * D + cc] = f2bf(gz);
        else if (sec == 3) Y[r * D + 512 + cc] = f2bf(gz);
        else { V[r * WA + cc] = gz; const float s1 = sum16(gz), s2 = sum16(gz * gz); if (col == 0) { float* p = vsts + (32 * rg + row) * 64 + ((c0 & 511) >> 4) * 2; p[0] = s1; p[1] = s2; } } }
}


template <int MAXU>
__device__ __forceinline__ void stage_rs(const Frame& F, const float* ssq, const pg8::StaticOrder& S) {
    LOCAL_IDS;
    LAS float* RS = (LAS float*)(F.lds + RS_LDS_OFF);
    f32x4 pa[MAXU][2]; bool ok[MAXU];
#pragma unroll
    for (int i = 0; i < MAXU; ++i) { pg8::Unit u; ok[i] = S.next(i, u);
        if (ok[i]) { const f32x4* p = (const f32x4*)(ssq + (size_t)(u.pm * 256 + (tid >> 1)) * 16 + (tid & 1) * 8); pa[i][0] = p[0]; pa[i][1] = p[1]; } }
#pragma unroll
    for (int i = 0; i < MAXU; ++i) if (ok[i]) {
        float sm = ((pa[i][0].x + pa[i][0].y) + (pa[i][0].z + pa[i][0].w)) + ((pa[i][1].x + pa[i][1].y) + (pa[i][1].z + pa[i][1].w));
        sm += __shfl_xor(sm, 1);
        if ((tid & 1) == 0) RS[i * 256 + (tid >> 1)] = rsqrtf(sm * (1.f / D) + EPS); }
    LBAR();
}

#define IN(k) (lo <= (k) && (k) < hi)
#define SEAM(k) do { if (IN(k) && IN((k) + 1)) xcd_barrier(F, (unsigned*)(kargs()->ws)); } while (0)
#define WS_PTRS const CArgs* ap = kargs(); unsigned char* ws = ap->ws; float* xres = ap->out; bf16_t* wl = (bf16_t*)(ws + WS_W) + (size_t)l * LW; \
    bf16_t* XB = (bf16_t*)(ws + WS_XB); bf16_t* HB = (bf16_t*)(ws + WS_HZ); bf16_t* YB = (bf16_t*)(ws + WS_Y); float* SSQ = (float*)(ws + WS_SSQ); \
    (void)xres; (void)wl; (void)XB; (void)HB; (void)YB; (void)SSQ
#define MINI_GU(Ain, Wgu, ssqs) do { const int half = F.G / 2; if (F.bid >= half) for (int mu = F.bid - half; mu < 4 * (FF / 16); mu += F.G - half) mini_gu(F, Ain, Wgu, ssqs, HB, mu); } while (0)
template <int l> __device__ __forceinline__ void layer_phases(const Frame& F, const int lo, const int hi) {
        const int pb = 1 + 8 * l;
        if (IN(pb + 0)) {
            WS_PTRS; pg8::Gemm g{YB, wl + OW_GU1, MPR, 2 * FF, D}; pg8::StaticOrder S; S.init(MPR, 2 * FF, F.G, F.bid); EpiGU E{HB, (const float*)(ws + WS_SSQ2)};
            stage_rs<6>(F, (const float*)(ws + WS_SSQ2), S);
            pg8::gemm_phase<EpiGU, pg8::StaticOrder, true, true>(F.lds, g, S, E, F.wave);
            MINI_GU(YB, wl + OW_GU1, (const float*)(ws + WS_SSQS_B)); }
        SEAM(pb + 0);
        if (IN(pb + 1)) {
            WS_PTRS; pg8::Gemm g{HB, wl + OW_D1, MPR, D, FF}; pg8::StaticOrder S; S.init(MPR, D, F.G, F.bid);
            EpiRes<0> E{YB, XB, SSQ, nullptr, nullptr, 0.5f};
            pg8::gemm_phase<EpiRes<0>, pg8::StaticOrder, true, true>(F.lds, g, S, E, F.wave);
            for (int mu = F.vcu; mu < 256; mu += F.G) mini_res<0>(F, HB, FF, wl + OW_D1, YB, XB, (float*)(ws + WS_SSQS_A), 0.5f, nullptr, nullptr, nullptr, mu); }
        SEAM(pb + 1);
        if (IN(pb + 2)) {
            WS_PTRS; pg8::Gemm g{XB, wl + OW_IN, MPR, INW, D}; pg8::StaticOrder S; S.init(MPR, INW, F.G, F.bid);
            EpiWin E{YB, (float*)(ws + WS_HZ), (float*)(ws + WS_HZ + (size_t)MP * WA * 4), (float*)(ws + WS_VST), SSQ};
            stage_rs<2>(F, SSQ, S);
            pg8::gemm_phase<EpiWin, pg8::StaticOrder, true, true>(F.lds, g, S, E, F.wave);
            for (int mu = F.vcu; mu < 512; mu += F.G) mini_win(F, XB, wl + OW_IN, (const float*)(ws + WS_SSQS_A), YB, (float*)(ws + WS_HZ), (float*)(ws + WS_HZ + (size_t)MP * WA * 4), (float*)(ws + WS_VSTS), mu); }
        SEAM(pb + 2);
        if (IN(pb + 3)) {
            {
                const int vcu = (F.G % 8 == 0) ? (F.bid % 8) * (F.G / 8) + F.bid / 8 : F.bid;
                for (int u = vcu; u < NB * 8 * 4; u += F.G) rglru_unit(F, l, u); }
            gmlp_units(F, l);
            for (int u = F.bid; u < MS; u += F.G) sample_mix_unit(F, l, u);
            LBAR(); }
        SEAM(pb + 3);
        if (IN(pb + 4)) {
            WS_PTRS; pg8::Gemm g{YB, wl + OW_OUT, MPR, D, D}; pg8::StaticOrder S; S.init(MPR, D, F.G, F.bid);
            EpiRes<0> E{XB, XB, SSQ, nullptr, nullptr, 1.0f};
            pg8::gemm_phase<EpiRes<0>, pg8::StaticOrder, true, true>(F.lds, g, S, E, F.wave);
            for (int mu = F.vcu; mu < 256; mu += F.G) mini_res<0>(F, YB, D, wl + OW_OUT, XB, XB, (float*)(ws + WS_SSQS_A), 1.0f, nullptr, nullptr, nullptr, mu); }
        SEAM(pb + 4);
        if (IN(pb + 5)) {
            WS_PTRS; pg8::Gemm g{XB, wl + OW_GU2, MPR, 2 * FF, D}; pg8::StaticOrder S; S.init(MPR, 2 * FF, F.G, F.bid); EpiGU E{HB, SSQ};
            stage_rs<6>(F, SSQ, S);
            pg8::gemm_phase<EpiGU, pg8::StaticOrder, true, true>(F.lds, g, S, E, F.wave);
            MINI_GU(XB, wl + OW_GU2, (const float*)(ws + WS_SSQS_A)); }
        SEAM(pb + 5);
        if (IN(pb + 6)) {
            WS_PTRS; pg8::Gemm g{HB, wl + OW_D2, MPR, D, FF}; pg8::StaticOrder S; S.init(MPR, D, F.G, F.bid);
            EpiRes<0> E{XB, XB, SSQ, nullptr, nullptr, 0.5f};
            pg8::gemm_phase<EpiRes<0>, pg8::StaticOrder, true, true>(F.lds, g, S, E, F.wave);
            for (int mu = F.vcu; mu < 256; mu += F.G) mini_res<0>(F, HB, FF, wl + OW_D2, XB, XB, (float*)(ws + WS_SSQS_A), 0.5f, nullptr, nullptr, nullptr, mu); }
        SEAM(pb + 6);
        if (IN(pb + 7)) {
            { WS_PTRS; pg8::Gemm g{(bf16_t*)(ws + WS_PB) + (size_t)l * MP * PLE, wl + OW_PP, MPR, D, PLE}; pg8::StaticOrder S; S.init(MPR, D, F.G, F.bid); EpiBf E{(bf16_t*)(ws + WS_HZ)};
              pg8::gemm_phase<EpiBf, pg8::StaticOrder, true, true>(F.lds, g, S, E, F.wave); }
            { WS_PTRS; pg8::Gemm g{XB, wl + OW_PG, MPR, D, D}; pg8::StaticOrder S; S.init(MPR, D, F.G, F.bid);
              EpiRes<1> E{XB, YB, (float*)(ws + WS_SSQ2), SSQ, (const bf16_t*)(ws + WS_HZ), 1.0f};
              stage_rs<1>(F, SSQ, S);
              pg8::gemm_phase<EpiRes<1>, pg8::StaticOrder, true, true>(F.lds, g, S, E, F.wave);
              for (int mu = F.vcu; mu < 256; mu += F.G) mini_res<1>(F, XB, D, wl + OW_PG, XB, YB, (float*)(ws + WS_SSQS_B), 1.0f, (const float*)(ws + WS_SSQS_A), (bf16_t*)(ws + WS_PB) + (size_t)l * MP * PLE, wl + OW_PP, mu); } }
        SEAM(pb + 7);
    }
#undef IN
#undef SEAM

__global__ void __launch_bounds__(NWAVES * 64, 2) fwd_kernel(Args a_unused) {
    extern __shared__ __attribute__((aligned(16))) unsigned char lds_raw[];
    Frame F;
    F.lds = (LAS unsigned char*)lds_raw;
    F.G = gridDim.x; F.bid = blockIdx.x; F.in = nullptr; F.wave = __builtin_amdgcn_readfirstlane((int)threadIdx.x >> 6);
    F.vcu = (F.G % 8 == 0) ? (F.bid % 8) * (F.G / 8) + F.bid / 8 : F.bid;
    int lo, hi; { const CArgs* ap = kargs(); lo = ap->ph_lo; hi = ap->ph_hi; }
    if (hi - lo > 1) {
        if (threadIdx.x < 2) ((volatile LAS unsigned*)(F.lds + 131072 + 64))[threadIdx.x] = 0u;
        __syncthreads();
        if (threadIdx.x == 0) (void)xb_add(&((unsigned*)(kargs()->ws))[XB_XCNT(xb_xcc_id())], 1u);
    }
#define IN(k) (lo <= (k) && (k) < hi)
#define SEAM(k) do { if (IN(k) && IN((k) + 1)) cg::this_grid().sync(); } while (0)
    if (IN(0)) { p0_prologue(F); }
    SEAM(0);
    layer_phases<0>(F, lo, hi);
    layer_phases<1>(F, lo, hi);
    if (IN(N_PHASES - 1)) {
        const CArgs* ap = kargs(); float* yout = ap->out; const float* SSQ = (const float*)(ap->ws + WS_SSQ2); const float* nf = ap->in[31]; const bf16_t* XF = (const bf16_t*)(ap->ws + WS_Y);
        LOCAL_IDS; const int gw = F.bid * NWAVES + w, NGW = F.G * NWAVES;
        if (gw < MV) {
            int m = gw; u32x2 xq[4]; f32x4 pa; f32x4 gn[4];
#pragma unroll
            for (int j = 0; j < 4; ++j) gn[j] = ((const f32x4*)nf)[lane + 64 * j];
#define F_LOAD(mm) do { pa = (mm) < MPR ? *(const f32x4*)(SSQ + (size_t)(mm) * 16 + (lane & 3) * 4) : *(const f32x4*)((const float*)(ap->ws + WS_SSQS_B) + ((mm) - MPR) * 64 + (lane & 15) * 4); \
            const u32x2* xr_ = (const u32x2*)(XF + (size_t)(mm) * D) + lane; _Pragma("unroll") for (int j = 0; j < 4; ++j) xq[j] = xr_[64 * j]; } while (0)
            f32x4 yv[4];
#define F_COMP(mm) do { float s_ = (pa.x + pa.y) + (pa.z + pa.w); s_ += __shfl_xor(s_, 1); s_ += __shfl_xor(s_, 2); \
            if ((mm) >= MPR) { s_ += __shfl_xor(s_, 4); s_ += __shfl_xor(s_, 8); } \
            const float rs_ = rsqrtf(s_ * (1.f / D) + EPS); \
            _Pragma("unroll") for (int j = 0; j < 4; ++j) yv[j] = unpk4(xq[j]) * rs_ * gn[j]; \
            asm volatile("" : "+v"(yv[0]), "+v"(yv[1]), "+v"(yv[2]), "+v"(yv[3])); } while (0)
            F_LOAD(m); F_COMP(m);
            bool has = m + NGW < MV; if (has) F_LOAD(m + NGW);
            for (;;) {
                f32x4* yo = (f32x4*)(yout + (size_t)m * D) + lane;
#pragma unroll
                for (int j = 0; j < 4; ++j) __builtin_nontemporal_store(yv[j], yo + 64 * j);
                if (!has) break;
                m += NGW; F_COMP(m);
                has = m + NGW < MV; if (has) F_LOAD(m + NGW);
            }
#undef F_COMP
#undef F_LOAD
        }
    }
#undef IN
#undef SEAM
#undef WS_PTRS
}

extern "C" void kernel_launch(void* const* d_in, const int* in_sizes, int n_in, void* d_out, int out_size, void* d_ws, size_t ws_size, hipStream_t stream) {
    static int grid = 0;
    if (grid == 0) {
        if (n_in != 32 || (size_t)out_size != OO_END || ws_size < WS_END) { fprintf(stderr, "kernel_launch: unexpected shapes (n_in %d, out %d, ws %zu, need %zu)\n", n_in, out_size, ws_size, (size_t)WS_END); grid = -1; return; }
        int dev = 0, cus = 0, per_cu = 0;
        if (hipGetDevice(&dev) != hipSuccess || hipDeviceGetAttribute(&cus, hipDeviceAttributeMultiprocessorCount, dev) != hipSuccess) { grid = -1; return; }
        if (hipFuncSetAttribute((const void*)fwd_kernel, hipFuncAttributeMaxDynamicSharedMemorySize, LDS_BYTES) != hipSuccess) { fprintf(stderr, "kernel_launch: hipFuncSetAttribute failed\n"); grid = -1; return; }
        if (hipOccupancyMaxActiveBlocksPerMultiprocessor(&per_cu, (const void*)fwd_kernel, NWAVES * 64, LDS_BYTES) != hipSuccess || per_cu < 1) { fprintf(stderr, "kernel_launch: occupancy query says %d\n", per_cu); per_cu = 1; }
        (void)hipGetLastError();
        grid = cus;
    }
    if (grid < 0) return;
    if (hipMemsetAsync(d_ws, 0, 16384, stream) != hipSuccess) { fprintf(stderr, "kernel_launch: memset failed\n"); return; }
    Args a{};
    for (int i = 0; i < 32; ++i) a.in[i] = (const float*)d_in[i];
    a.out = (float*)d_out; a.ws = (unsigned char*)d_ws;
#ifdef PROBE_LIST
    {
        const int plist[] = PROBE_LIST;
        for (unsigned i = 0; i < sizeof(plist) / sizeof(plist[0]); ++i) { a.ph_lo = plist[i]; a.ph_hi = plist[i] + 1; hipLaunchKernelGGL(fwd_kernel, dim3(grid), dim3(NWAVES * 64), LDS_BYTES, stream, a); }
    }
#endif
#if ONE_LAUNCH
    a.ph_lo = 0; a.ph_hi = N_PHASES;
    void* args[] = {&a};
    hipError_t e = hipLaunchCooperativeKernel((const void*)fwd_kernel, dim3(grid), dim3(NWAVES * 64), args, LDS_BYTES, stream);
    if (e != hipSuccess) fprintf(stderr, "cooperative launch failed: %s (grid %d)\n", hipGetErrorString(e), grid);
#else
    for (int p = 0; p < N_PHASES; ++p) {
        a.ph_lo = p; a.ph_hi = p + 1;
        hipLaunchKernelGGL(fwd_kernel, dim3(grid), dim3(NWAVES * 64), LDS_BYTES, stream, a);
    }
#endif
}
```

```cpp
#include <hip/hip_runtime.h>
#include <hip/hip_cooperative_groups.h>
#include <cstdio>
#include <cstdint>
namespace cg = cooperative_groups;

#ifndef ONE_LAUNCH
#define ONE_LAUNCH 1
#endif

namespace pg8 {
#define PG8_LAS __attribute__((address_space(3)))
typedef unsigned short bf16_t;
typedef short bf16x8 __attribute__((ext_vector_type(8)));
typedef float f32x4 __attribute__((ext_vector_type(4)));
typedef unsigned u32x4 __attribute__((ext_vector_type(4)));
typedef unsigned u32x2 __attribute__((ext_vector_type(2)));
constexpr int BM = 256, BK = 64, HALF = 128, HTB = HALF * BK * 2, STAGE_BYTES = 8 * HTB, NXCD = 8, WGM = 8;

__host__ __device__ __forceinline__ int lds_byte(int r, int c) { const int st = (r >> 4) * 2 + (c >> 5), rr = r & 15, cc = c & 31, ob = rr * 64 + cc * 2; return st * 1024 + (ob ^ (((ob >> 9) & 1) << 5)); }
__host__ __device__ __forceinline__ void stage_rc(int b, int& R, int& C) { const int st = b / 1024, sb = b % 1024, swz = sb ^ (((sb >> 9) & 1) << 5); R = (st >> 1) * 16 + swz / 64; C = (st & 1) * 32 + (swz % 64) / 2; }
__host__ __device__ __forceinline__ int perm32(int rho) { const int n = rho >> 4, i = rho & 15; return 8 * (i >> 2) + 4 * n + (i & 3); }

struct Unit { int pm, pn; };
struct Gemm { const bf16_t* A; const bf16_t* Bt; int M, N, K; };

struct StaticOrder {
    int nM, nN, nwg, G, c;
    __host__ __device__ void init(int M, int N, int G_, int c_) { nM = M / BM; nN = N / BM; nwg = nM * nN; G = G_; c = c_; }
    __host__ __device__ bool next(int i, Unit& u) const {
        const long L = (long)i * G + c; if (L >= nwg) return false;
        int wgid = (int)L; { const int q = nwg / NXCD, r = nwg % NXCD, xcd = wgid % NXCD, off = wgid / NXCD; wgid = (xcd < r ? xcd * (q + 1) : r * (q + 1) + (xcd - r) * q) + off; }
        const int nig = WGM * nN, gid = wgid / nig, fm = gid * WGM, gsz = (nM - fm) < WGM ? (nM - fm) : WGM;
        u.pm = fm + ((wgid % nig) % gsz); u.pn = (wgid % nig) / gsz; return true;
    }
    __device__ __forceinline__ void a_ready(const Unit&) const {}
    __device__ __forceinline__ void done(const Unit&) const {}
};

__device__ __forceinline__ unsigned cvt_pk_bf16(float lo, float hi) { unsigned r; asm("v_cvt_pk_bf16_f32 %0, %1, %2" : "=v"(r) : "v"(lo), "v"(hi)); return r; }

template <class Epi, class Sched, bool ALIGN_EPI = false, bool SP2 = false>
__device__ __forceinline__ void gemm_phase(PG8_LAS unsigned char* lds, const Gemm g, const Sched& S, const Epi& E, const int wid) {
    int lane_ = (int)__builtin_amdgcn_mbcnt_hi(~0u, __builtin_amdgcn_mbcnt_lo(~0u, 0u)); asm volatile("" : "+v"(lane_));
    const int lane = lane_, tid = wid * 64 + lane, wr = wid >> 2, wc = wid & 3, fr = lane & 15, fq = lane >> 4;
    const int K = g.K, nt = K / BK;
    unsigned voffA[2], voffB[2];
#pragma unroll
    for (int i = 0; i < 2; ++i) { int R, C; stage_rc(tid * 16 + i * 8192, R, C); const int Rb = Epi::PERM ? ((R & ~31) + perm32(R & 31)) : R;
        voffA[i] = (unsigned)(R * K + C) * 2u; voffB[i] = (unsigned)(Rb * K + C) * 2u; }
    const size_t kstep = (size_t)(BK * 2);
    const size_t hstep = (size_t)HALF * K * 2;
    const size_t tstep = 2 * hstep;
    const unsigned ldsw = (unsigned)wid * 1024u;
    const int aoff = lds_byte(wr * 64 + fr, fq * 8), boff = lds_byte(wc * 32 + fr, fq * 8);
#define PG8_SA(b, h) (((b) * 2 + (h)) * HTB)
#define PG8_SB(b, h) ((4 + (b) * 2 + (h)) * HTB)
#define PG8_STAGE(bufoff, gbase, voff) do { _Pragma("unroll") for (int _i = 0; _i < 2; ++_i) \
        __builtin_amdgcn_global_load_lds((const unsigned*)((const char*)(gbase) + (voff)[_i]), (PG8_LAS unsigned*)(lds + (bufoff) + ldsw + _i * 8192), 16, 0, 0); } while (0)
#define PG8_LDA(dst, b, h) do { _Pragma("unroll") for (int m = 0; m < 4; ++m) _Pragma("unroll") for (int k = 0; k < 2; ++k) dst[m][k] = *(const PG8_LAS bf16x8*)(lds + PG8_SA(b, h) + aoff + m * 2048 + k * 1024); } while (0)
#define PG8_LDB(dst, b, h) do { _Pragma("unroll") for (int n = 0; n < 2; ++n) _Pragma("unroll") for (int k = 0; k < 2; ++k) dst[n][k] = *(const PG8_LAS bf16x8*)(lds + PG8_SB(b, h) + boff + n * 2048 + k * 1024); } while (0)
#define PG8_MMA(ai, bj, At, Bt) do { __builtin_amdgcn_s_setprio(1); _Pragma("unroll") for (int m = 0; m < 4; ++m) _Pragma("unroll") for (int n = 0; n < 2; ++n) _Pragma("unroll") for (int k = 0; k < 2; ++k) \
        acc[ai][bj][m][n] = __builtin_amdgcn_mfma_f32_16x16x32_bf16(Bt[n][k], At[m][k], acc[ai][bj][m][n], 0, 0, 0); __builtin_amdgcn_s_setprio(0); } while (0)
#define PG8_WAIT_V(n) asm volatile("s_waitcnt vmcnt(" #n ")" ::: "memory")
#define PG8_WAIT_L(n) asm volatile("s_waitcnt lgkmcnt(" #n ")" ::: "memory")
#define PG8_BAR __builtin_amdgcn_s_barrier()
#define PG8_SCHED __builtin_amdgcn_sched_barrier(0)
    Unit cur, nxt; int ui = 0;
    if (!S.next(0, cur)) return;
    f32x4 acc[2][2][4][2];
#pragma unroll
    for (int a = 0; a < 2; ++a)
#pragma unroll
        for (int b = 0; b < 2; ++b)
#pragma unroll
            for (int m = 0; m < 4; ++m)
#pragma unroll
                for (int n = 0; n < 2; ++n) acc[a][b][m][n] = (f32x4){0.f, 0.f, 0.f, 0.f};
    bf16x8 At[4][2], B0[2][2], B1[2][2];
    const char* cA = (const char*)g.A + (size_t)cur.pm * tstep; const char* cB = (const char*)g.Bt + (size_t)cur.pn * tstep;
    S.a_ready(cur);
    if constexpr (SP2) {
        PG8_STAGE(PG8_SB(0, 0), cB, voffB); PG8_STAGE(PG8_SB(0, 1), cB + hstep, voffB); PG8_STAGE(PG8_SA(0, 0), cA, voffA); PG8_STAGE(PG8_SA(0, 1), cA + hstep, voffA);
        if (wr == 1) PG8_BAR;
        PG8_WAIT_V(2); PG8_BAR;
        PG8_STAGE(PG8_SB(1, 0), cB + kstep, voffB); PG8_STAGE(PG8_SA(1, 0), cA + kstep, voffA); PG8_STAGE(PG8_SB(1, 1), cB + hstep + kstep, voffB);
        PG8_WAIT_V(6); PG8_BAR;
    } else {
        PG8_STAGE(PG8_SB(0, 0), cB, voffB); PG8_STAGE(PG8_SA(0, 0), cA, voffA); PG8_STAGE(PG8_SB(0, 1), cB + hstep, voffB); PG8_STAGE(PG8_SA(0, 1), cA + hstep, voffA);
        if (wr == 1) PG8_BAR;
        PG8_WAIT_V(4); PG8_BAR;
        PG8_STAGE(PG8_SB(1, 0), cB + kstep, voffB); PG8_STAGE(PG8_SA(1, 0), cA + kstep, voffA); PG8_STAGE(PG8_SB(1, 1), cB + hstep + kstep, voffB);
        PG8_WAIT_V(6); PG8_BAR;
    }
    for (;;) {
        const bool has_next = S.next(ui + 1, nxt);
        const char* nA = has_next ? (const char*)g.A + (size_t)nxt.pm * tstep : cA; const char* nB = has_next ? (const char*)g.Bt + (size_t)nxt.pn * tstep : cB;
        for (int t = 0; t < nt; t += 2) {
            const bool last = (t == nt - 2);
            const char* a1 = cA + (size_t)(t + 1) * kstep;
            const char* a2 = last ? nA : cA + (size_t)(t + 2) * kstep; const char* b2 = last ? nB : cB + (size_t)(t + 2) * kstep;
            const char* a3 = a2 + kstep; const char* b3 = b2 + kstep;
            if (last && has_next) S.a_ready(nxt);
            if constexpr (SP2) {
            PG8_LDB(B0, 0, 0); PG8_LDB(B1, 0, 1); PG8_SCHED; PG8_LDA(At, 0, 0); PG8_STAGE(PG8_SA(1, 1), a1 + hstep, voffA);
            PG8_WAIT_V(8); PG8_WAIT_L(0); PG8_BAR; PG8_MMA(0, 0, At, B0); PG8_MMA(0, 1, At, B1); PG8_BAR; PG8_SCHED;
            PG8_LDA(At, 0, 1); PG8_STAGE(PG8_SB(0, 0), b2, voffB); PG8_STAGE(PG8_SB(0, 1), b2 + hstep, voffB); PG8_STAGE(PG8_SA(0, 0), a2, voffA);
            PG8_WAIT_V(8); PG8_WAIT_L(0); PG8_BAR; PG8_MMA(1, 0, At, B0); PG8_MMA(1, 1, At, B1); PG8_BAR; PG8_SCHED;
            PG8_LDB(B0, 1, 0); PG8_LDB(B1, 1, 1); PG8_SCHED; PG8_LDA(At, 1, 0); PG8_STAGE(PG8_SA(0, 1), a2 + hstep, voffA);
            PG8_WAIT_V(8); PG8_WAIT_L(0); PG8_BAR; PG8_MMA(0, 0, At, B0); PG8_MMA(0, 1, At, B1); PG8_BAR; PG8_SCHED;
            PG8_LDA(At, 1, 1); PG8_STAGE(PG8_SB(1, 0), b3, voffB); PG8_STAGE(PG8_SB(1, 1), b3 + hstep, voffB); PG8_STAGE(PG8_SA(1, 0), a3, voffA);
            PG8_WAIT_V(8); PG8_WAIT_L(0); PG8_BAR; PG8_MMA(1, 0, At, B0); PG8_MMA(1, 1, At, B1); PG8_BAR; PG8_SCHED;
            } else {
            PG8_LDB(B0, 0, 0); PG8_SCHED; PG8_LDA(At, 0, 0); PG8_STAGE(PG8_SA(1, 1), a1 + hstep, voffA);
            PG8_WAIT_L(8); PG8_BAR; PG8_WAIT_L(0); PG8_MMA(0, 0, At, B0); PG8_BAR; PG8_SCHED;
            PG8_LDB(B1, 0, 1); PG8_STAGE(PG8_SB(0, 0), b2, voffB);
            PG8_BAR; PG8_WAIT_L(0); PG8_MMA(0, 1, At, B1); PG8_BAR;
            PG8_LDA(At, 0, 1); PG8_STAGE(PG8_SA(0, 0), a2, voffA);
            PG8_BAR; PG8_WAIT_L(0); PG8_MMA(1, 0, At, B0); PG8_BAR; PG8_SCHED;
            PG8_STAGE(PG8_SB(0, 1), b2 + hstep, voffB);
            PG8_WAIT_V(6); PG8_BAR; PG8_MMA(1, 1, At, B1); PG8_BAR;
            PG8_LDB(B0, 1, 0); PG8_SCHED; PG8_LDA(At, 1, 0); PG8_STAGE(PG8_SA(0, 1), a2 + hstep, voffA);
            PG8_WAIT_L(8); PG8_BAR; PG8_WAIT_L(0); PG8_MMA(0, 0, At, B0); PG8_BAR; PG8_SCHED;
            PG8_LDB(B1, 1, 1); PG8_STAGE(PG8_SB(1, 0), b3, voffB);
            PG8_BAR; PG8_WAIT_L(0); PG8_MMA(0, 1, At, B1); PG8_BAR;
            PG8_LDA(At, 1, 1); PG8_STAGE(PG8_SA(1, 0), a3, voffA);
            PG8_BAR; PG8_WAIT_L(0); PG8_MMA(1, 0, At, B0); PG8_BAR; PG8_SCHED;
            PG8_STAGE(PG8_SB(1, 1), b3 + hstep, voffB);
            PG8_WAIT_V(6); PG8_BAR; PG8_MMA(1, 1, At, B1); PG8_BAR;
            }
        }
        if constexpr (ALIGN_EPI) { if (wr == 0) PG8_BAR; }
        E(acc, cur, (const PG8_LAS float*)(lds + (131072 + 1024)) + ui * 256, wr, wc, fr, fq); S.done(cur);
        if (!has_next) break;
#pragma unroll
        for (int a = 0; a < 2; ++a)
#pragma unroll
            for (int b = 0; b < 2; ++b)
#pragma unroll
                for (int m = 0; m < 4; ++m)
#pragma unroll
                    for (int n = 0; n < 2; ++n) acc[a][b][m][n] = (f32x4){0.f, 0.f, 0.f, 0.f};
        cur = nxt; cA = nA; cB = nB; ++ui;
        if constexpr (ALIGN_EPI) { if (wr == 1) PG8_BAR; }
    }
    PG8_WAIT_V(0);
    if constexpr (!ALIGN_EPI) { if (wr == 0) PG8_BAR; }
    PG8_BAR;
#undef PG8_SA
#undef PG8_SB
#undef PG8_STAGE
#undef PG8_LDA
#undef PG8_LDB
#undef PG8_MMA
#undef PG8_WAIT_V
#undef PG8_WAIT_L
#undef PG8_BAR
#undef PG8_SCHED
}
}

using pg8::bf16_t; using pg8::bf16x8; using pg8::f32x4; using pg8::u32x4; using pg8::u32x2; using pg8::cvt_pk_bf16;
#define LAS __attribute__((address_space(3)))
constexpr int NWAVES = 8;
constexpr int D = 1024, FF = 2816, WA = 512, WB = 512, PLE = 256, INW = 2048, DEPTH = 2;
constexpr int NB = 8, SEQ = 2048, MPR = NB * SEQ  , MS = 128  , MV = MPR + MS  , MP = 16640  ;
constexpr float EPS = 1e-6f;
constexpr size_t OW_GU1 = 0, OW_D1 = OW_GU1 + (size_t)2 * FF * D, OW_IN = OW_D1 + (size_t)D * FF, OW_OUT = OW_IN + (size_t)INW * D, OW_GU2 = OW_OUT + (size_t)D * D,
                 OW_D2 = OW_GU2 + (size_t)2 * FF * D, OW_PG = OW_D2 + (size_t)D * FF, OW_PP = OW_PG + (size_t)D * D, LW = OW_PP + (size_t)D * PLE;
constexpr size_t al256(size_t x) { return (x + 255) & ~(size_t)255; }
constexpr size_t WS_W = 1u << 20;
constexpr size_t WS_XB = al256(WS_W + 2 * LW * 2);
constexpr size_t WS_HZ = al256(WS_XB + (size_t)MP * D * 2);
constexpr size_t HZ_BYTES = (size_t)MP * FF * 2;
constexpr size_t WS_Y = al256(WS_HZ + HZ_BYTES);
constexpr size_t WS_PB = al256(WS_Y + (size_t)MP * D * 2);
constexpr size_t WS_SSQ = al256(WS_PB + (size_t)2 * MP * PLE * 2);
constexpr size_t WS_VST = al256(WS_SSQ + (size_t)MP * 16 * 4);
constexpr size_t WS_SSQ2 = al256(WS_VST + (size_t)MP * 16 * 4);
constexpr size_t WS_SSQS_A = al256(WS_SSQ2 + (size_t)MP * 16 * 4);
constexpr size_t WS_SSQS_B = WS_SSQS_A + 128 * 64 * 4;
constexpr size_t WS_VSTS = WS_SSQS_B + 128 * 64 * 4;
constexpr size_t WS_END = al256(WS_VSTS + 128 * 64 * 4);
static_assert((size_t)MP * 512 * 4 * 2 <= HZ_BYTES && (size_t)MP * D * 4 <= HZ_BYTES, "overlay");
constexpr size_t OO_YS = (size_t)MPR * D, OO_HP = OO_YS + (size_t)MS * D, OO_CP = OO_HP + (size_t)DEPTH * NB * WB, OO_HS = OO_CP + (size_t)DEPTH * NB * 3 * WB,
                 OO_CS = OO_HS + (size_t)DEPTH * MS * WB, OO_CV = OO_CS + (size_t)DEPTH * MS * 3 * WB, OO_END = OO_CV + (size_t)DEPTH * MS * WA;
constexpr int LDS_BYTES = 147456;

__device__ __forceinline__ float fsig(float x) { return __builtin_amdgcn_rcpf(1.f + __expf(-x)); }
__device__ __forceinline__ float fsilu(float x) { return x * fsig(x); }
__device__ __forceinline__ float fgelu(float x) { return x * fsig(1.5957691216f * (x + 0.044715f * x * x * x)); }
__device__ __forceinline__ float bf2f(unsigned short h) { return __builtin_bit_cast(float, (unsigned)h << 16); }
__device__ __forceinline__ unsigned short f2bf(float f) { return (unsigned short)(cvt_pk_bf16(f, 0.f) & 0xffffu); }
__device__ __forceinline__ float wave_sum(float v) {
#pragma unroll
    for (int o = 1; o < 64; o <<= 1) v += __shfl_xor(v, o);
    return v;
}
#define RS_LDS_OFF (131072 + 1024)
__device__ __forceinline__ float row_rstd(const float* ssq, int row, int fq) {
    const f32x4 a = *(const f32x4*)(ssq + (size_t)row * 16 + fq * 4);
    float s = (a.x + a.y) + (a.z + a.w);
    s += __shfl_xor(s, 16); s += __shfl_xor(s, 32);
    return rsqrtf(s * (1.f / D) + EPS);
}

struct EpiGU {
    static constexpr bool PERM = true;
    bf16_t* H; const float* ssq;
    __device__ __forceinline__ void operator()(const f32x4 (&acc)[2][2][4][2], const pg8::Unit& u, const LAS float* rsu, int wr, int wc, int fr, int fq) const {
        const int row0 = u.pm * 256 + wr * 64 + fr, col0 = u.pn * 128 + wc * 32 + 8 * fq;
#pragma unroll
        for (int ai = 0; ai < 2; ++ai)
#pragma unroll
            for (int m = 0; m < 4; ++m) {
                const int r = row0 + ai * 128 + m * 16; const float rs = rsu[ai * 128 + wr * 64 + m * 16 + fr];
                const f32x4 g0 = acc[ai][0][m][0] * rs, g1 = acc[ai][0][m][1] * rs, u0 = acc[ai][1][m][0] * rs, u1 = acc[ai][1][m][1] * rs;
                u32x4 w;
                w.x = cvt_pk_bf16(fsilu(g0[0]) * u0[0], fsilu(g0[1]) * u0[1]); w.y = cvt_pk_bf16(fsilu(g0[2]) * u0[2], fsilu(g0[3]) * u0[3]);
                w.z = cvt_pk_bf16(fsilu(g1[0]) * u1[0], fsilu(g1[1]) * u1[1]); w.w = cvt_pk_bf16(fsilu(g1[2]) * u1[2], fsilu(g1[3]) * u1[3]);
                *(u32x4*)(H + (size_t)r * FF + col0) = w;
            }
    }
};
__device__ __forceinline__ f32x4 unpk4(u32x2 w) { return (f32x4){__builtin_bit_cast(float, w.x << 16), __builtin_bit_cast(float, w.x & 0xffff0000u), __builtin_bit_cast(float, w.y << 16), __builtin_bit_cast(float, w.y & 0xffff0000u)}; }
template <int MODE> struct EpiRes {
    static constexpr bool PERM = true;
    const bf16_t* xin; bf16_t* xout; float* ssq_out; const float* ssq_in; const bf16_t* pp; float scale;
    __device__ __forceinline__ void operator()(const f32x4 (&acc)[2][2][4][2], const pg8::Unit& u, const LAS float* rsu, int wr, int wc, int fr, int fq) const {
        const int col0 = u.pn * 256 + wc * 32 + 8 * fq;
#pragma unroll
        for (int ai = 0; ai < 2; ++ai)
#pragma unroll
            for (int m = 0; m < 4; ++m) {
                const int r = u.pm * 256 + ai * 128 + wr * 64 + m * 16 + fr;
                float rs = 1.f; if (MODE == 1) rs = rsu[ai * 128 + wr * 64 + m * 16 + fr];
                float q = 0.f;
#pragma unroll
                for (int bj = 0; bj < 2; ++bj) {
                    const size_t off = (size_t)r * D + col0 + bj * 128;
                    const u32x4 bw = *(const u32x4*)(xin + off);
                    const f32x4 b0 = unpk4((u32x2){bw.x, bw.y}), b1 = unpk4((u32x2){bw.z, bw.w});
                    f32x4 o0, o1;
                    if (MODE == 0) { o0 = b0 + acc[ai][bj][m][0] * scale; o1 = b1 + acc[ai][bj][m][1] * scale; }
                    else { const u32x4 pw = *(const u32x4*)(pp + off); const f32x4 p0 = unpk4((u32x2){pw.x, pw.y}), p1 = unpk4((u32x2){pw.z, pw.w});
                           const f32x4 z0 = acc[ai][bj][m][0] * rs, z1 = acc[ai][bj][m][1] * rs;
                           o0 = b0 + (f32x4){fsig(z0[0]), fsig(z0[1]), fsig(z0[2]), fsig(z0[3])} * p0; o1 = b1 + (f32x4){fsig(z1[0]), fsig(z1[1]), fsig(z1[2]), fsig(z1[3])} * p1; }
                    u32x4 w; w.x = cvt_pk_bf16(o0[0], o0[1]); w.y = cvt_pk_bf16(o0[2], o0[3]); w.z = cvt_pk_bf16(o1[0], o1[1]); w.w = cvt_pk_bf16(o1[2], o1[3]);
                    *(u32x4*)(xout + off) = w;
                    const f32x4 r0 = unpk4((u32x2){w.x, w.y}), r1 = unpk4((u32x2){w.z, w.w});
                    q += ((r0[0] * r0[0] + r0[1] * r0[1]) + (r0[2] * r0[2] + r0[3] * r0[3])) + ((r1[0] * r1[0] + r1[1] * r1[1]) + (r1[2] * r1[2] + r1[3] * r1[3]));
                }
                q += __shfl_xor(q, 16); q += __shfl_xor(q, 32);
                if (fq == 0) ssq_out[(size_t)r * 16 + u.pn * 4 + wc] = q;
            }
    }
};
struct EpiWin {
    static constexpr bool PERM = true;
    bf16_t* Y; float* V; float* XR; float* vst; const float* ssq;
    __device__ __forceinline__ void operator()(const f32x4 (&acc)[2][2][4][2], const pg8::Unit& u, const LAS float* rsu, int wr, int wc, int fr, int fq) const {
        const int sec = u.pn >> 1, cb = (u.pn & 1) * 256 + wc * 32 + 8 * fq;
#pragma unroll
        for (int ai = 0; ai < 2; ++ai)
#pragma unroll
            for (int m = 0; m < 4; ++m) {
                const int r = u.pm * 256 + ai * 128 + wr * 64 + m * 16 + fr; const float rs = rsu[ai * 128 + wr * 64 + m * 16 + fr];
                float s1 = 0.f, s2 = 0.f;
#pragma unroll
                for (int bj = 0; bj < 2; ++bj) {
                    const int c = cb + bj * 128; const f32x4 z0 = acc[ai][bj][m][0] * rs, z1 = acc[ai][bj][m][1] * rs;
                    if (sec == 2) { *(f32x4*)(XR + (size_t)r * WB + c) = z0; *(f32x4*)(XR + (size_t)r * WB + c + 4) = z1; }
                    else {
                        const f32x4 g0 = (f32x4){fgelu(z0[0]), fgelu(z0[1]), fgelu(z0[2]), fgelu(z0[3])}, g1 = (f32x4){fgelu(z1[0]), fgelu(z1[1]), fgelu(z1[2]), fgelu(z1[3])};
                        if (sec == 1) { *(f32x4*)(V + (size_t)r * WA + c) = g0; *(f32x4*)(V + (size_t)r * WA + c + 4) = g1;
                            s1 += ((g0[0] + g0[1]) + (g0[2] + g0[3])) + ((g1[0] + g1[1]) + (g1[2] + g1[3]));
                            s2 += ((g0[0] * g0[0] + g0[1] * g0[1]) + (g0[2] * g0[2] + g0[3] * g0[3])) + ((g1[0] * g1[0] + g1[1] * g1[1]) + (g1[2] * g1[2] + g1[3] * g1[3])); }
                        else { u32x4 w; w.x = cvt_pk_bf16(g0[0], g0[1]); w.y = cvt_pk_bf16(g0[2], g0[3]); w.z = cvt_pk_bf16(g1[0], g1[1]); w.w = cvt_pk_bf16(g1[2], g1[3]);
                            *(u32x4*)(Y + (size_t)r * D + (sec == 3 ? 512 : 0) + c) = w; }
                    }
                }
                if (sec == 1) {
                    s1 += __shfl_xor(s1, 16); s1 += __shfl_xor(s1, 32); s2 += __shfl_xor(s2, 16); s2 += __shfl_xor(s2, 32);
                    if (fq == 0) { float* p = vst + (size_t)r * 16 + ((u.pn & 1) * 4 + wc) * 2; p[0] = s1; p[1] = s2; }
                }
            }
    }
};
struct EpiBf {
    static constexpr bool PERM = true;
    bf16_t* O;
    __device__ __forceinline__ void operator()(const f32x4 (&acc)[2][2][4][2], const pg8::Unit& u, const LAS float* rsu, int wr, int wc, int fr, int fq) const {
        const int col0 = u.pn * 256 + wc * 32 + 8 * fq;
#pragma unroll
        for (int ai = 0; ai < 2; ++ai)
#pragma unroll
            for (int m = 0; m < 4; ++m) {
                const int r = u.pm * 256 + ai * 128 + wr * 64 + m * 16 + fr;
#pragma unroll
                for (int bj = 0; bj < 2; ++bj) { const f32x4 v0 = acc[ai][bj][m][0], v1 = acc[ai][bj][m][1];
                    u32x4 w; w.x = cvt_pk_bf16(v0[0], v0[1]); w.y = cvt_pk_bf16(v0[2], v0[3]); w.z = cvt_pk_bf16(v1[0], v1[1]); w.w = cvt_pk_bf16(v1[2], v1[3]);
                    *(u32x4*)(O + (size_t)r * D + col0 + bj * 128) = w; }
            }
    }
};

struct Frame {
    LAS unsigned char* lds;
    int G, bid, wave, vcu;
    const float* const* in;
};
struct Args { const float* in[32]; float* out; unsigned char* ws; int ph_lo, ph_hi; };
typedef const Args CArgs;
__device__ __forceinline__ const CArgs* kargs() {
#if defined(__HIP_DEVICE_COMPILE__)
    auto p = __builtin_amdgcn_kernarg_segment_ptr(); asm volatile("" : "+s"(p)); return (const CArgs*)p;
#else
    return nullptr;
#endif
}

#define LOCAL_IDS int lane_l = (int)__builtin_amdgcn_mbcnt_hi(~0u, __builtin_amdgcn_mbcnt_lo(~0u, 0u)); asm volatile("" : "+v"(lane_l)); const int lane = lane_l, w = F.wave, tid = w * 64 + lane; (void)tid

#define XB_TMO      128
#define XB_XCNT(j)  (256  + 64 * (j))
#define XB_XSUB(j)  (1280 + 64 * (j))
#define XB_XGEN(j)  (2304 + 64 * (j))
#define XB_TOP      3328
#define XB_TOPGEN   3392
#define XCD_BAR_WORDS 3456
#define XB_SPIN_CAP (1u << 18)
__device__ __forceinline__ unsigned xb_ld(unsigned* p)              { return __hip_atomic_load(p, __ATOMIC_RELAXED, __HIP_MEMORY_SCOPE_AGENT); }
__device__ __forceinline__ unsigned xb_add(unsigned* p, unsigned v) { return __hip_atomic_fetch_add(p, v, __ATOMIC_RELAXED, __HIP_MEMORY_SCOPE_AGENT); }
__device__ __forceinline__ unsigned xb_xcc_id() { return (unsigned)__builtin_amdgcn_s_getreg((3 << 11) | 20) & 0xFu; }
#define XB_SPIN(cond, bar) do { unsigned _sp = 0; while (cond) { __builtin_amdgcn_s_sleep(1); \
    if ((++_sp & 255u) == 0u) { if (xb_ld(&(bar)[XB_TMO])) break; if (_sp > XB_SPIN_CAP) { atomicAdd(&(bar)[XB_TMO], 1u); break; } } } } while (0)
__device__ __forceinline__ void xcd_barrier_complete(unsigned* bar, unsigned x, unsigned G, unsigned& nloc, unsigned& nx) {
    unsigned sum, cnt, mine, sp = 0u;
    for (;;) {
        sum = 0u; cnt = 0u; mine = 0u;
#pragma unroll
        for (unsigned j = 0; j < 16; ++j) { const unsigned c = xb_ld(&bar[XB_XCNT(j)]); sum += c; cnt += (c > 0u) ? 1u : 0u; mine = (j == x) ? c : mine; }
        if (sum == G) break;
        __builtin_amdgcn_s_sleep(1);
        if ((++sp & 255u) == 0u) { if (xb_ld(&bar[XB_TMO])) break; if (sp > XB_SPIN_CAP) { atomicAdd(&bar[XB_TMO], 1u); break; } }
    }
    nloc = mine > 0u ? mine : 1u; nx = cnt > 0u ? cnt : 1u;
}
__device__ __forceinline__ void xcd_barrier(const Frame& F, unsigned* bar) {
    volatile LAS unsigned* st = (volatile LAS unsigned*)(F.lds + 131072 + 64);
    const int lane_b = (int)__builtin_amdgcn_mbcnt_hi(~0u, __builtin_amdgcn_mbcnt_lo(~0u, 0u));
    asm volatile("s_waitcnt vmcnt(0)" ::: "memory");
    __syncthreads();
    if (F.wave == 0 && lane_b == 0) {
        __builtin_amdgcn_s_waitcnt(0);
        const unsigned x = xb_xcc_id();
        unsigned nloc = st[0], nx = st[1];
        if (nloc == 0u) { xcd_barrier_complete(bar, x, (unsigned)F.G, nloc, nx); st[0] = nloc; st[1] = nx; }
        const unsigned old = xb_add(&bar[XB_XSUB(x)], 1u);
        const unsigned gen = old / nloc;
        if (old + 1u == (gen + 1u) * nloc) {
            __builtin_amdgcn_fence(__ATOMIC_RELEASE, "agent");
            asm volatile("s_waitcnt vmcnt(0)" ::: "memory");
            const unsigned og = xb_add(&bar[XB_TOP], 1u);
            const unsigned tg = og / nx;
            if (og + 1u == (tg + 1u) * nx) xb_add(&bar[XB_TOPGEN], 1u);
            else XB_SPIN(xb_ld(&bar[XB_TOPGEN]) == tg, bar);
            __builtin_amdgcn_fence(__ATOMIC_ACQUIRE, "agent");
            xb_add(&bar[XB_XGEN(x)], 1u);
            asm volatile("s_waitcnt vmcnt(0)" ::: "memory");
        } else {
            XB_SPIN(xb_ld(&bar[XB_XGEN(x)]) == gen, bar);
            __builtin_amdgcn_fence(__ATOMIC_ACQUIRE, "agent");
            asm volatile("s_waitcnt vmcnt(0)" ::: "memory");
        }
    }
    __syncthreads();
}
#define LDS_WAIT() asm volatile("s_waitcnt lgkmcnt(0)" ::: "memory")
#define LBAR() do { asm volatile("s_waitcnt lgkmcnt(0)" ::: "memory"); __builtin_amdgcn_s_barrier(); asm volatile("" ::: "memory"); } while (0)

struct TItem { const float* W; const float* gain; bf16_t* WT; int K, N, mode, item; };
__device__ __forceinline__ TItem p0_decode(const Args& a, bf16_t* Wb, int it) {
    constexpr int I_G = (D / 64) * (FF / 32), I_D = (FF / 64) * (D / 32), I_IN = (D / 64) * (INW / 32), I_O = (D / 64) * (D / 32), I_PP = (PLE / 64) * (D / 32);
    constexpr int PER_LAYER = 4 * I_G + 2 * I_D + I_IN + 2 * I_O + I_PP;
    const int l = it / PER_LAYER; int r = it % PER_LAYER; bf16_t* wl = Wb + (size_t)l * LW;
    if (r < I_G) return TItem{a.in[7] + (size_t)l * D * FF, a.in[6] + l * D, wl + OW_GU1, D, FF, 1, r}; r -= I_G;
    if (r < I_G) return TItem{a.in[8] + (size_t)l * D * FF, a.in[6] + l * D, wl + OW_GU1, D, FF, 2, r}; r -= I_G;
    if (r < I_D) return TItem{a.in[9] + (size_t)l * D * FF, nullptr, wl + OW_D1, FF, D, 0, r}; r -= I_D;
    if (r < I_IN) return TItem{a.in[11] + (size_t)l * D * INW, a.in[10] + l * D, wl + OW_IN, D, INW, 0, r}; r -= I_IN;
    if (r < I_O) return TItem{a.in[23] + (size_t)l * D * D, nullptr, wl + OW_OUT, D, D, 0, r}; r -= I_O;
    if (r < I_G) return TItem{a.in[25] + (size_t)l * D * FF, a.in[24] + l * D, wl + OW_GU2, D, FF, 1, r}; r -= I_G;
    if (r < I_G) return TItem{a.in[26] + (size_t)l * D * FF, a.in[24] + l * D, wl + OW_GU2, D, FF, 2, r}; r -= I_G;
    if (r < I_D) return TItem{a.in[27] + (size_t)l * D * FF, nullptr, wl + OW_D2, FF, D, 0, r}; r -= I_D;
    if (r < I_O) return TItem{a.in[29] + (size_t)l * D * D, a.in[28] + l * D, wl + OW_PG, D, D, 0, r}; r -= I_O;
    return TItem{a.in[30] + (size_t)l * PLE * D, nullptr, wl + OW_PP, PLE, D, 0, r};
}
__device__ __forceinline__ void ti_load(const TItem& t, int lane, float (&v)[32], f32x4 (&g)[2]) {
    const int nblk = t.N / 32, kb = t.item / nblk, nb = t.item % nblk, k0 = 64 * kb, n0 = 32 * nb;
    const float* p = t.W + (size_t)(k0 + (lane >> 5)) * t.N + n0 + (lane & 31);
#pragma unroll
    for (int i = 0; i < 32; ++i) v[i] = __builtin_nontemporal_load(p + (size_t)(2 * i) * t.N);
    g[0] = (f32x4){1.f, 1.f, 1.f, 1.f}; g[1] = g[0];
    if (t.gain) { const f32x4* gp = (const f32x4*)(t.gain + k0 + 8 * (lane & 7)); g[0] = gp[0]; g[1] = gp[1]; }
}
__device__ __forceinline__ void ti_lds(LAS float* scr, int lane, const float (&v)[32]) {
#pragma unroll
    for (int i = 0; i < 32; ++i) scr[(2 * i + (lane >> 5)) * 33 + (lane & 31)] = v[i];
}
__device__ __forceinline__ void ti_store(const TItem& t, LAS float* scr, int lane, const f32x4 (&g)[2]) {
    const int nblk = t.N / 32, kb = t.item / nblk, nb = t.item % nblk, k0 = 64 * kb, n0 = 32 * nb;
    const int drow0 = t.mode == 0 ? n0 : (256 * (n0 >> 7) + (n0 & 127) + (t.mode == 2 ? 128 : 0));
    const int c = lane & 7;
    float sv[4][8];
#pragma unroll
    for (int j = 0; j < 4; ++j) { const LAS float* sp = scr + (8 * c) * 33 + (lane >> 3) + 8 * j;
#pragma unroll
        for (int e = 0; e < 8; ++e) sv[j][e] = sp[e * 33]; }
#pragma unroll
    for (int j = 0; j < 4; ++j) { const int n = (lane >> 3) + 8 * j;
        u32x4 o; o.x = cvt_pk_bf16(sv[j][0] * g[0].x, sv[j][1] * g[0].y); o.y = cvt_pk_bf16(sv[j][2] * g[0].z, sv[j][3] * g[0].w);
        o.z = cvt_pk_bf16(sv[j][4] * g[1].x, sv[j][5] * g[1].y); o.w = cvt_pk_bf16(sv[j][6] * g[1].z, sv[j][7] * g[1].w);
        *(u32x4*)(t.WT + (size_t)(drow0 + n) * t.K + k0 + 8 * c) = o; }
}

__device__ __forceinline__ void p0_prologue(const Frame& F) {
    const CArgs* ap = kargs(); const Args& a = *ap;
    LOCAL_IDS;
    LAS float* scr = (LAS float*)(F.lds + w * 16384);
    const int gw = F.bid * NWAVES + w, NGW = F.G * NWAVES;
    bf16_t* Wb = (bf16_t*)(a.ws + WS_W);
    constexpr int I_G = (D / 64) * (FF / 32), I_D = (FF / 64) * (D / 32), I_IN = (D / 64) * (INW / 32), I_O = (D / 64) * (D / 32), I_PP = (PLE / 64) * (D / 32);
    constexpr int NIT = DEPTH * (4 * I_G + 2 * I_D + I_IN + 2 * I_O + I_PP);
    if (gw < NIT) {
        int it = gw; TItem cur = p0_decode(a, Wb, it), nxt = cur; float v[32]; f32x4 g[2], g2[2]; ti_load(cur, lane, v, g);
        ti_lds(scr, lane, v);
        LDS_WAIT(); asm volatile("" ::: "memory");
        bool has = it + NGW < NIT; g2[0] = g[0]; g2[1] = g[1];
        if (has) { nxt = p0_decode(a, Wb, it + NGW); ti_load(nxt, lane, v, g2); }
        for (;;) {
            ti_store(cur, scr, lane, g);
            if (!has) break;
            LDS_WAIT(); asm volatile("" ::: "memory");
            ti_lds(scr, lane, v);
            LDS_WAIT(); asm volatile("" ::: "memory");
            cur = nxt; g[0] = g2[0]; g[1] = g2[1]; it += NGW;
            has = it + NGW < NIT;
            if (has) { nxt = p0_decode(a, Wb, it + NGW); ti_load(nxt, lane, v, g2); }
        }
        LDS_WAIT(); asm volatile("" ::: "memory");
    }
    bf16_t* XB = (bf16_t*)(a.ws + WS_Y); float* SSQ = (float*)(a.ws + WS_SSQ2);
    if (gw < MV) {
        int m = gw; f32x4 v[4]; float sq = 0.f; u32x2 wq[4];
#define X_LOAD(mm) do { const f32x4* xr_ = (const f32x4*)((mm) < MPR ? a.in[0] + (size_t)(mm) * D : a.in[1] + (size_t)((mm) - MPR) * D) + lane; \
        _Pragma("unroll") for (int j = 0; j < 4; ++j) v[j] = __builtin_nontemporal_load(xr_ + 64 * j); } while (0)
#define X_PACK() do { sq = 0.f; _Pragma("unroll") for (int j = 0; j < 4; ++j) { sq += (v[j].x * v[j].x + v[j].y * v[j].y) + (v[j].z * v[j].z + v[j].w * v[j].w); \
        wq[j].x = cvt_pk_bf16(v[j].x, v[j].y); wq[j].y = cvt_pk_bf16(v[j].z, v[j].w); } \
        asm volatile("" : "+v"(wq[0].x), "+v"(wq[0].y), "+v"(wq[1].x), "+v"(wq[1].y), "+v"(wq[2].x), "+v"(wq[2].y), "+v"(wq[3].x), "+v"(wq[3].y), "+v"(sq)); } while (0)
        X_LOAD(m); X_PACK();
        bool has = m + NGW < MV; if (has) X_LOAD(m + NGW);
        for (;;) {
            const float s = wave_sum(sq);
            u32x2* o8 = (u32x2*)(XB + (size_t)m * D) + lane;
#pragma unroll
            for (int j = 0; j < 4; ++j) o8[64 * j] = wq[j];
            if (m < MPR) { if (lane < 16) SSQ[(size_t)m * 16 + lane] = lane == 0 ? s : 0.f; }
            else ((float*)(a.ws + WS_SSQS_B))[(m - MPR) * 64 + lane] = lane == 0 ? s : 0.f;
            if (!has) break;
            m += NGW; X_PACK();
            has = m + NGW < MV; if (has) X_LOAD(m + NGW);
        }
#undef X_LOAD
#undef X_PACK
    }
    bf16_t* PB = (bf16_t*)(a.ws + WS_PB);
    if (gw < DEPTH * MV) {
        int i = gw; f32x4 v; u32x2 wq;
#define P_LOAD(ii) do { const int l_ = (ii) / MV, m_ = (ii) % MV; v = __builtin_nontemporal_load((const f32x4*)(m_ < MPR ? a.in[4] + ((size_t)l_ * MPR + m_) * PLE : a.in[5] + ((size_t)l_ * MS + (m_ - MPR)) * PLE) + lane); } while (0)
#define P_PACK() do { wq.x = cvt_pk_bf16(v.x, v.y); wq.y = cvt_pk_bf16(v.z, v.w); asm volatile("" : "+v"(wq.x), "+v"(wq.y)); } while (0)
        P_LOAD(i); P_PACK();
        bool has = i + NGW < DEPTH * MV; if (has) P_LOAD(i + NGW);
        for (;;) {
            ((u32x2*)(PB + ((size_t)(i / MV) * MP + (i % MV)) * PLE))[lane] = wq;
            if (!has) break;
            i += NGW; P_PACK();
            has = i + NGW < DEPTH * MV; if (has) P_LOAD(i + NGW);
        }
#undef P_LOAD
#undef P_PACK
    }
}

__device__ __forceinline__ void rglru_unit(const Frame& F, int l, int unit) {
    const CArgs* ap = kargs(); const Args& a = *ap;
    const int b = unit >> 5, hb = (unit >> 2) & 7, sub = unit & 3;
    LOCAL_IDS; const int fr = lane & 15, fq = lane >> 4;
    LAS bf16_t* XC = (LAS bf16_t*)F.lds;
    LAS float* XCF = (LAS float*)(F.lds + 18432);
    LAS float* SUM = (LAS float*)(F.lds + 18432 + 8192);
    const float* XR = (const float*)(a.ws + WS_HZ + (size_t)MP * WA * 4);
    bf16_t* Y = (bf16_t*)(a.ws + WS_Y);
    const size_t row0 = (size_t)b * SEQ;
    const int chh = hb * 64, ch = chh + sub * 16 + fr;
    const int c4 = (tid & 15) * 4, tk = tid >> 4;
    f32x4 cw[4];
#pragma unroll
    for (int k = 0; k < 4; ++k) cw[k] = *(const f32x4*)(a.in[16] + ((size_t)l * 4 + k) * WB + chh + c4);
    const f32x4 cbias = *(const f32x4*)(a.in[17] + (size_t)l * WB + chh + c4);
    bf16x8 Br[2], Bi[2];
    {
        const float* wrp = a.in[18] + ((size_t)(l * 8 + hb) * 64) * 64 + sub * 16 + fr;
        const float* wip = a.in[20] + ((size_t)(l * 8 + hb) * 64) * 64 + sub * 16 + fr;
#pragma unroll
        for (int ks = 0; ks < 2; ++ks)
#pragma unroll
            for (int e = 0; e < 8; e += 2) {
                const int i0 = 32 * ks + 8 * fq + e;
                const unsigned pr = cvt_pk_bf16(wrp[(size_t)i0 * 64], wrp[(size_t)(i0 + 1) * 64]), pi = cvt_pk_bf16(wip[(size_t)i0 * 64], wip[(size_t)(i0 + 1) * 64]);
                Br[ks][e] = (short)(pr & 0xffffu); Br[ks][e + 1] = (short)(pr >> 16); Bi[ks][e] = (short)(pi & 0xffffu); Bi[ks][e + 1] = (short)(pi >> 16);
            }
    }
    const float br = a.in[19][l * WB + ch], bi = a.in[21][l * WB + ch];
    const float c8 = -8.f * log1pf(expf(-a.in[22][l * WB + ch]));
    const int tg = tid >> 4;
    f32x4 xr[11];
#define RG_LOAD(it_) do { _Pragma("unroll") for (int i2 = 0; i2 < 11; ++i2) { const int tt = 256 * (it_) + 8 * tg - 3 + i2; \
        xr[i2] = tt >= 0 ? *(const f32x4*)(XR + (row0 + tt) * WB + chh + c4) : (f32x4){0.f, 0.f, 0.f, 0.f}; } } while (0)
    LAS bf16_t* XC2 = (LAS bf16_t*)F.lds;
    LAS float* XCF2 = (LAS float*)(F.lds + 36864);
    LAS float* SUM2 = (LAS float*)(F.lds + 36864 + 16384);
    RG_LOAD(0);
    float hcar = 0.f;
    LBAR();
    for (int it = 0; it < SEQ / 256; ++it) {
#pragma unroll
        for (int j2 = 0; j2 < 8; ++j2) {
            f32x4 xc = cbias;
#pragma unroll
            for (int k = 0; k < 4; ++k) xc += xr[j2 + k] * cw[k];
            const int tok = 8 * tg + j2;
            u32x2 pk; pk.x = cvt_pk_bf16(xc[0], xc[1]); pk.y = cvt_pk_bf16(xc[2], xc[3]);
            *(LAS u32x2*)(XC2 + tok * 72 + c4) = pk;
            if ((c4 >> 4) == sub) *(LAS f32x4*)(XCF2 + tok * 16 + (c4 & 15)) = xc;
        }
        if (it + 1 < SEQ / 256) RG_LOAD(it + 1);
        bf16_t* yp = Y + (row0 + 256 * it + 32 * w + 4 * fq) * D + 512 + ch;
        float gt[2][4];
#pragma unroll
        for (int t2 = 0; t2 < 2; ++t2)
#pragma unroll
            for (int j2 = 0; j2 < 4; ++j2) gt[t2][j2] = bf2f(yp[(size_t)(16 * t2 + j2) * D]);
        LBAR();
        float Pj[2][4], Hj[2][4], Pl[2], Hl[2], Pe[2], He[2];
#pragma unroll
        for (int t2 = 0; t2 < 2; ++t2) {
            const int trow = 32 * w + 16 * t2;
            const bf16x8 a0 = *(const LAS bf16x8*)(XC2 + (trow + fr) * 72 + 8 * fq), a1 = *(const LAS bf16x8*)(XC2 + (trow + fr) * 72 + 32 + 8 * fq);
            f32x4 accr = (f32x4){0.f, 0.f, 0.f, 0.f}, acci = (f32x4){0.f, 0.f, 0.f, 0.f};
            accr = __builtin_amdgcn_mfma_f32_16x16x32_bf16(a0, Br[0], accr, 0, 0, 0); accr = __builtin_amdgcn_mfma_f32_16x16x32_bf16(a1, Br[1], accr, 0, 0, 0);
            acci = __builtin_amdgcn_mfma_f32_16x16x32_bf16(a0, Bi[0], acci, 0, 0, 0); acci = __builtin_amdgcn_mfma_f32_16x16x32_bf16(a1, Bi[1], acci, 0, 0, 0);
#pragma unroll
            for (int j2 = 0; j2 < 4; ++j2) {
                const float xcf = XCF2[(trow + 4 * fq + j2) * 16 + fr];
                const float rg = fsig(accr[j2] + br), ig = fsig(acci[j2] + bi);
                const float la = c8 * rg, av = __expf(la), uv = sqrtf(fmaxf(1.f - __expf(2.f * la), 0.f)) * (ig * xcf);
                if (j2 == 0) { Pj[t2][0] = av; Hj[t2][0] = uv; } else { Pj[t2][j2] = av * Pj[t2][j2 - 1]; Hj[t2][j2] = av * Hj[t2][j2 - 1] + uv; }
            }
            Pl[t2] = Pj[t2][3]; Hl[t2] = Hj[t2][3];
        }
#pragma unroll
        for (int t2 = 0; t2 < 2; ++t2) {
            float Pp = __shfl_up(Pl[t2], 16), Hp = __shfl_up(Hl[t2], 16);
            if (fq >= 1) { Hl[t2] = Pl[t2] * Hp + Hl[t2]; Pl[t2] = Pl[t2] * Pp; }
            Pp = __shfl_up(Pl[t2], 32); Hp = __shfl_up(Hl[t2], 32);
            if (fq >= 2) { Hl[t2] = Pl[t2] * Hp + Hl[t2]; Pl[t2] = Pl[t2] * Pp; }
            Pe[t2] = __shfl_up(Pl[t2], 16); He[t2] = __shfl_up(Hl[t2], 16);
            if (fq == 0) { Pe[t2] = 1.f; He[t2] = 0.f; }
        }
        const float P0t = __shfl(Pl[0], 48 + fr), H0t = __shfl(Hl[0], 48 + fr);
        if (fq == 3) { SUM2[(w * 16 + fr) * 2] = Pl[1] * P0t; SUM2[(w * 16 + fr) * 2 + 1] = Pl[1] * H0t + Hl[1]; }
        LBAR();
        float carry = hcar, cwv = hcar;
#pragma unroll
        for (int w2 = 0; w2 < 8; ++w2) { const float Pw = SUM2[(w2 * 16 + fr) * 2], Hw = SUM2[(w2 * 16 + fr) * 2 + 1]; if (w2 == w) cwv = carry; carry = Pw * carry + Hw; }
        hcar = carry;
        const float c1w = P0t * cwv + H0t;
#pragma unroll
        for (int t2 = 0; t2 < 2; ++t2) {
            const float cl = Pe[t2] * (t2 == 0 ? cwv : c1w) + He[t2];
#pragma unroll
            for (int j2 = 0; j2 < 4; ++j2) { const float h = Pj[t2][j2] * cl + Hj[t2][j2]; yp[(size_t)(16 * t2 + j2) * D] = f2bf(h * gt[t2][j2]); }
        }
    }
#undef RG_LOAD
    if (w == 0 && fq == 0) a.out[OO_HP + ((size_t)l * NB + b) * WB + ch] = hcar;
    if (tid < 48) { const int k = tid >> 4, c = chh + sub * 16 + (tid & 15);
        a.out[OO_CP + (((size_t)l * NB + b) * 3 + k) * WB + c] = XR[(row0 + SEQ - 3 + k) * WB + c]; }
}

__device__ __forceinline__ void gmlp_units(const Frame& F, int l) {
    const CArgs* ap = kargs(); const Args& a = *ap;
    LOCAL_IDS; const int fr = lane & 15, fq = lane >> 4;
    constexpr int NU = NB * 16 * 8;
    int u = F.bid, ustep = F.G, uend = NU;
    if (F.G == 256) { const int x = F.bid & 7, j = F.bid >> 3; u = x * 128 + (j >> 3) * 8 + (j & 7); ustep = 32; uend = x * 128 + 128; }
    if (u >= uend) return;
    LAS bf16_t* VT = (LAS bf16_t*)F.lds;
    const float* V = (const float*)(a.ws + WS_HZ); const float* VST = (const float*)(a.ws + WS_VST);
    bf16_t* Y = (bf16_t*)(a.ws + WS_Y);
    const int irow = 16 * w + fr, tok = tid >> 2, d0 = (tid & 3) * 16;
    int hc = -1; bf16x8 Wf[4]; f32x4 gq[4], bq[4]; float bs = 0.f;
    f32x4 st, vv[4]; u32x2 uv[4], uvc[4];
#define G_CONST(h_) do { hc = (h_); const float* wsp = a.in[14] + (((size_t)l * 8 + hc) * 128 + irow) * 128; \
        _Pragma("unroll") for (int ks = 0; ks < 4; ++ks) { \
            if (ks <= (w >> 1)) { const int j0 = 32 * ks + 8 * fq; const f32x4 w0 = *(const f32x4*)(wsp + j0), w1 = *(const f32x4*)(wsp + j0 + 4); \
                float e[8] = {w0[0], w0[1], w0[2], w0[3], w1[0], w1[1], w1[2], w1[3]}; \
                _Pragma("unroll") for (int q = 0; q < 8; q += 2) { const unsigned pk = cvt_pk_bf16(j0 + q <= irow ? e[q] : 0.f, j0 + q + 1 <= irow ? e[q + 1] : 0.f); Wf[ks][q] = (short)(pk & 0xffffu); Wf[ks][q + 1] = (short)(pk >> 16); } \
            } else { Wf[ks] = (bf16x8){0, 0, 0, 0, 0, 0, 0, 0}; } } \
        _Pragma("unroll") for (int q = 0; q < 4; ++q) { gq[q] = *(const f32x4*)(a.in[12] + (size_t)l * WA + hc * 64 + 16 * q + (d0 >> 2)); bq[q] = *(const f32x4*)(a.in[13] + (size_t)l * WA + hc * 64 + 16 * q + (d0 >> 2)); } \
        bs = a.in[15][((size_t)l * 8 + hc) * 128 + irow]; } while (0)
#define G_LOAD(uu) do { const int h_ = (uu) & 7; const size_t r0_ = (size_t)((uu) >> 3) * 128, row_ = r0_ + tok; \
        st = *(const f32x4*)(VST + row_ * 16 + (tid & 3) * 4); \
        _Pragma("unroll") for (int q = 0; q < 4; ++q) vv[q] = *(const f32x4*)(V + row_ * WA + h_ * 64 + 16 * q + (d0 >> 2)); \
        const bf16_t* yp_ = Y + (r0_ + irow) * D + h_ * 64 + 4 * fq; \
        _Pragma("unroll") for (int nt = 0; nt < 4; ++nt) uv[nt] = *(const u32x2*)(yp_ + 16 * nt); } while (0)
#define G_LN() do { float s1 = st[0] + st[2], s2 = st[1] + st[3]; \
        s1 += __shfl_xor(s1, 1); s1 += __shfl_xor(s1, 2); s2 += __shfl_xor(s2, 1); s2 += __shfl_xor(s2, 2); \
        const float mean = s1 * (1.f / WA), rstd = rsqrtf(fmaxf(s2 * (1.f / WA) - mean * mean, 0.f) + EPS); \
        _Pragma("unroll") for (int q = 0; q < 4; ++q) { const f32x4 o = (vv[q] - mean) * rstd * gq[q] + bq[q]; \
            _Pragma("unroll") for (int e = 0; e < 4; ++e) VT[(16 * q + (d0 >> 2) + e) * 136 + tok] = f2bf(o[e]); } \
        _Pragma("unroll") for (int nt = 0; nt < 4; ++nt) uvc[nt] = uv[nt]; } while (0)
    G_LOAD(u); G_CONST(u & 7);
    LBAR();
    G_LN();
    bool has = u + ustep < uend; if (has) G_LOAD(u + ustep);
    for (;;) {
        LBAR();
        f32x4 acc[4];
#pragma unroll
        for (int nt = 0; nt < 4; ++nt) acc[nt] = (f32x4){0.f, 0.f, 0.f, 0.f};
#pragma unroll
        for (int ks = 0; ks < 4; ++ks) {
            if (ks <= (w >> 1)) {
#pragma unroll
                for (int nt = 0; nt < 4; ++nt) {
                    const bf16x8 av = *(const LAS bf16x8*)(VT + (16 * nt + fr) * 136 + 32 * ks + 8 * fq);
                    acc[nt] = __builtin_amdgcn_mfma_f32_16x16x32_bf16(av, Wf[ks], acc[nt], 0, 0, 0);
                }
            }
        }
        LBAR();
        bf16_t* yp = Y + ((size_t)(u >> 3) * 128 + irow) * D + (u & 7) * 64 + 4 * fq;
#pragma unroll
        for (int nt = 0; nt < 4; ++nt) {
            const float u0 = bf2f((unsigned short)(uvc[nt].x & 0xffffu)), u1 = bf2f((unsigned short)(uvc[nt].x >> 16)), u2 = bf2f((unsigned short)(uvc[nt].y & 0xffffu)), u3 = bf2f((unsigned short)(uvc[nt].y >> 16));
            u32x2 o; o.x = cvt_pk_bf16(u0 * (acc[nt][0] + bs), u1 * (acc[nt][1] + bs)); o.y = cvt_pk_bf16(u2 * (acc[nt][2] + bs), u3 * (acc[nt][3] + bs));
            *(u32x2*)(yp + 16 * nt) = o;
        }
        if (!has) break;
        u += ustep;
        if ((u & 7) != hc) G_CONST(u & 7);
        G_LN();
        has = u + ustep < uend; if (has) G_LOAD(u + ustep);
    }
#undef G_CONST
#undef G_LOAD
#undef G_LN
}

__device__ __forceinline__ float sum16(float s) { s += __shfl_xor(s, 1); s += __shfl_xor(s, 2); s += __shfl_xor(s, 4); s += __shfl_xor(s, 8); return s; }
__device__ __forceinline__ void sample_mix_unit(const Frame& F, int l, int sb) {
    const CArgs* ap = kargs(); const Args& a = *ap;
    LOCAL_IDS; const int c = tid;
    LAS float* xcs = (LAS float*)F.lds;
    const size_t row = (size_t)MPR + sb;
    const float* V = (const float*)(a.ws + WS_HZ); const float* XR = (const float*)(a.ws + WS_HZ + (size_t)MP * WA * 4); const float* VST = (const float*)(a.ws + WS_VSTS);
    bf16_t* Y = (bf16_t*)(a.ws + WS_Y);
    const int h = c >> 6, j = c & 63;
    const f32x4 stp = *(const f32x4*)(VST + sb * 64 + (c & 15) * 4);
    const float vraw = V[row * WA + c], lng = a.in[12][l * WA + c], lnb = a.in[13][l * WA + c];
    const float ws00 = a.in[14][((size_t)l * 8 + h) * 128 * 128], bs0 = a.in[15][((size_t)l * 8 + h) * 128];
    const float yu = bf2f(Y[row * D + c]), yg = bf2f(Y[row * D + 512 + c]);
    const float xr = XR[row * WB + c];
    const float* sc = a.in[3] + ((size_t)l * MS + sb) * 3 * WB;
    const float b0 = sc[c], b1 = sc[WB + c], b2 = sc[2 * WB + c];
    const float* cwp = a.in[16] + (size_t)l * 4 * WB;
    const float cw0 = cwp[c], cw1 = cwp[WB + c], cw2 = cwp[2 * WB + c], cw3 = cwp[3 * WB + c], cbv = a.in[17][l * WB + c];
    const float brv = a.in[19][l * WB + c], biv = a.in[21][l * WB + c], lamv = a.in[22][l * WB + c], h0 = a.in[2][((size_t)l * MS + sb) * WB + c];
    const float* wrp = a.in[18] + ((size_t)(l * 8 + h) * 64) * 64 + j; const float* wip = a.in[20] + ((size_t)(l * 8 + h) * 64) * 64 + j;
    float wrv[64], wiv[64];
#pragma unroll
    for (int i = 0; i < 64; ++i) { wrv[i] = wrp[(size_t)i * 64]; wiv[i] = wip[(size_t)i * 64]; }
    const float s1 = sum16(stp.x + stp.z), s2 = sum16(stp.y + stp.w);
    const float mean = s1 * (1.f / WA), rstd = rsqrtf(fmaxf(s2 * (1.f / WA) - mean * mean, 0.f) + EPS);
    const float vln = (vraw - mean) * rstd * lng + lnb;
    const float sg = ws00 * vln + bs0;
    const float xc = cbv + b0 * cw0 + b1 * cw1 + b2 * cw2 + xr * cw3;
    LBAR();
    xcs[c] = xc;
    LBAR();
    float ar = brv, ai = biv;
#pragma unroll
    for (int i = 0; i < 64; ++i) { const float x = xcs[h * 64 + i]; ar += x * wrv[i]; ai += x * wiv[i]; }
    const float rg = fsig(ar), ig = fsig(ai);
    const float la = -8.f * log1pf(expf(-lamv)) * rg;
    const float av = __expf(la), uv = sqrtf(fmaxf(1.f - __expf(2.f * la), 0.f)) * (ig * xc);
    const float hn = av * h0 + uv;
    a.out[OO_CV + ((size_t)l * MS + sb) * WA + c] = vln;
    Y[row * D + c] = f2bf(yu * sg);
    a.out[OO_HS + ((size_t)l * MS + sb) * WB + c] = hn;
    float* co = a.out + OO_CS + ((size_t)l * MS + sb) * 3 * WB;
    co[c] = b1; co[WB + c] = b2; co[2 * WB + c] = xr;
    Y[row * D + 512 + c] = f2bf(hn * yg);
}

constexpr int N_PHASES = 2 + 8 * DEPTH;


template <int NBM, int BATCH = (NBM == 1 ? 12 : 6)>
__device__ __forceinline__ void mini_core(LAS unsigned char* lds, const bf16_t* Arow, int lda, const bf16_t* B0, const bf16_t* B1, int K, int w, int lane, float& v0, float& v1) {
    const int fr = lane & 15, fq = lane >> 4;
    const int Kw = K >> 3, nsteps = Kw >> 5, k0 = w * Kw + 8 * fq;
    const bf16_t* pa0 = Arow + (size_t)fr * lda + k0; const bf16_t* pa1 = pa0 + (size_t)16 * lda;
    const bf16_t* pb0 = B0 + (size_t)fr * K + k0; const bf16_t* pb1 = B1 + (size_t)fr * K + k0;
    f32x4 acc00 = (f32x4){0.f, 0.f, 0.f, 0.f}, acc01 = acc00, acc10 = acc00, acc11 = acc00;
    for (int s0 = 0; s0 < nsteps; s0 += BATCH) {
        bf16x8 a0[BATCH], a1[BATCH], b0[BATCH], b1[BATCH];
#pragma unroll
        for (int i = 0; i < BATCH; ++i) if (s0 + i < nsteps) { const int ko = (s0 + i) * 32;
            a0[i] = *(const bf16x8*)(pa0 + ko); a1[i] = *(const bf16x8*)(pa1 + ko); b0[i] = *(const bf16x8*)(pb0 + ko); if (NBM == 2) b1[i] = *(const bf16x8*)(pb1 + ko); }
#pragma unroll
        for (int i = 0; i < BATCH; ++i) if (s0 + i < nsteps) {
            acc00 = __builtin_amdgcn_mfma_f32_16x16x32_bf16(b0[i], a0[i], acc00, 0, 0, 0); acc01 = __builtin_amdgcn_mfma_f32_16x16x32_bf16(b0[i], a1[i], acc01, 0, 0, 0);
            if (NBM == 2) { acc10 = __builtin_amdgcn_mfma_f32_16x16x32_bf16(b1[i], a0[i], acc10, 0, 0, 0); acc11 = __builtin_amdgcn_mfma_f32_16x16x32_bf16(b1[i], a1[i], acc11, 0, 0, 0); } }
    }
    LAS float* P = (LAS float*)lds;
    *(LAS f32x4*)(P + ((0 * 8 + w) * 32 + fr) * 16 + 4 * fq) = acc00; *(LAS f32x4*)(P + ((0 * 8 + w) * 32 + 16 + fr) * 16 + 4 * fq) = acc01;
    if (NBM == 2) { *(LAS f32x4*)(P + ((8 + w) * 32 + fr) * 16 + 4 * fq) = acc10; *(LAS f32x4*)(P + ((8 + w) * 32 + 16 + fr) * 16 + 4 * fq) = acc11; }
    LBAR();
    const int t = w * 64 + lane; float s0_ = 0.f, s1_ = 0.f;
#pragma unroll
    for (int w2 = 0; w2 < 8; ++w2) { s0_ += P[w2 * 512 + t]; if (NBM == 2) s1_ += P[(8 + w2) * 512 + t]; }
    v0 = s0_; v1 = s1_;
    LBAR();
}
__device__ __forceinline__ float srow_rstd(const float* ssqs, int srow, int col) {
    const f32x4 a = *(const f32x4*)(ssqs + srow * 64 + col * 4); float s = (a.x + a.y) + (a.z + a.w);
    s += __shfl_xor(s, 1); s += __shfl_xor(s, 2); s += __shfl_xor(s, 4); s += __shfl_xor(s, 8);
    return rsqrtf(s * (1.f / D) + EPS);
}

__device__ __forceinline__ void mini_gu(const Frame& F, const bf16_t* Ain, const bf16_t* Wgu, const float* ssqs, bf16_t* H, int mu) {
    LOCAL_IDS; const int rg = mu & 3, c0 = (mu >> 2) * 16, row = tid >> 4, col = tid & 15;
    const bf16_t* B0 = Wgu + (size_t)(256 * (c0 >> 7) + (c0 & 127)) * D;
    const float rs = srow_rstd(ssqs, 32 * rg + row, col);
    float g, u; mini_core<2>(F.lds, Ain + (size_t)(MPR + 32 * rg) * D, D, B0, B0 + (size_t)128 * D, D, w, lane, g, u);
    H[(size_t)(MPR + 32 * rg + row) * FF + c0 + col] = f2bf(fsilu(g * rs) * (u * rs));
}
template <int MODE>
__device__ __forceinline__ void mini_res(const Frame& F, const bf16_t* Ain, int K, const bf16_t* W, const bf16_t* xin, bf16_t* xout, float* ssqs_out, float scale,
                                         const float* ssqs_in, const bf16_t* Pin, const bf16_t* Wp, int mu) {
    LOCAL_IDS; const int rg = mu & 3, cg = mu >> 2, c0 = cg * 16, row = tid >> 4, col = tid & 15;
    const size_t off = (size_t)(MPR + 32 * rg + row) * D + c0 + col;
    const float xb0 = bf2f(xin[off]); float rs = 1.f; if (MODE == 1) rs = srow_rstd(ssqs_in, 32 * rg + row, col);
    float v, dummy; mini_core<1>(F.lds, Ain + (size_t)(MPR + 32 * rg) * K, K, W + (size_t)c0 * K, W + (size_t)c0 * K, K, w, lane, v, dummy);
    float o;
    if (MODE == 0) o = xb0 + scale * v;
    else { float pv; mini_core<1>(F.lds, Pin + (size_t)(MPR + 32 * rg) * PLE, PLE, Wp + (size_t)c0 * PLE, Wp + (size_t)c0 * PLE, PLE, w, lane, pv, dummy);
           o = xb0 + fsig(v * rs) * pv; }
    const unsigned short ob = f2bf(o); xout[off] = ob;
    const float orr = bf2f(ob), q = sum16(orr * orr);
    if (col == 0) ssqs_out[(32 * rg + row) * 64 + cg] = q;
}
__device__ __forceinline__ void mini_win(const Frame& F, const bf16_t* Ain, const bf16_t* W, const float* ssqs, bf16_t* Y, float* V, float* XR, float* vsts, int mu) {
    LOCAL_IDS; const int rg = mu & 3, cg = mu >> 2, c0 = cg * 16, row = tid >> 4, col = tid & 15;
    const float rsw = srow_rstd(ssqs, 32 * rg + row, col);
    float v, dummy; mini_core<1>(F.lds, Ain + (size_t)(MPR + 32 * rg) * D, D, W + (size_t)c0 * D, W + (size_t)c0 * D, D, w, lane, v, dummy);
    const float z = v * rsw;
    const int sec = c0 >> 9, cc = (c0 & 511) + col; const size_t r = (size_t)MPR + 32 * rg + row;
    if (sec == 2) XR[r * WB + cc] = z;
    else { const float gz = fgelu(z);
        if (sec == 0) Y[r * D + cc] = f2bf(gz);
        else if (sec == 3) Y[r * D + 512 + cc] = f2bf(gz);
        else { V[r * WA + cc] = gz; const float s1 = sum16(gz), s2 = sum16(gz * gz); if (col == 0) { float* p = vsts + (32 * rg + row) * 64 + ((c0 & 511) >> 4) * 2; p[0] = s1; p[1] = s2; } } }
}


template <int MAXU>
__device__ __forceinline__ void stage_rs(const Frame& F, const float* ssq, const pg8::StaticOrder& S) {
    LOCAL_IDS;
    LAS float* RS = (LAS float*)(F.lds + RS_LDS_OFF);
    f32x4 pa[MAXU][2]; bool ok[MAXU];
#pragma unroll
    for (int i = 0; i < MAXU; ++i) { pg8::Unit u; ok[i] = S.next(i, u);
        if (ok[i]) { const f32x4* p = (const f32x4*)(ssq + (size_t)(u.pm * 256 + (tid >> 1)) * 16 + (tid & 1) * 8); pa[i][0] = p[0]; pa[i][1] = p[1]; } }
#pragma unroll
    for (int i = 0; i < MAXU; ++i) if (ok[i]) {
        float sm = ((pa[i][0].x + pa[i][0].y) + (pa[i][0].z + pa[i][0].w)) + ((pa[i][1].x + pa[i][1].y) + (pa[i][1].z + pa[i][1].w));
        sm += __shfl_xor(sm, 1);
        if ((tid & 1) == 0) RS[i * 256 + (tid >> 1)] = rsqrtf(sm * (1.f / D) + EPS); }
    LBAR();
}

#define IN(k) (lo <= (k) && (k) < hi)
#define SEAM(k) do { if (IN(k) && IN((k) + 1)) xcd_barrier(F, (unsigned*)(kargs()->ws)); } while (0)
#define WS_PTRS const CArgs* ap = kargs(); unsigned char* ws = ap->ws; float* xres = ap->out; bf16_t* wl = (bf16_t*)(ws + WS_W) + (size_t)l * LW; \
    bf16_t* XB = (bf16_t*)(ws + WS_XB); bf16_t* HB = (bf16_t*)(ws + WS_HZ); bf16_t* YB = (bf16_t*)(ws + WS_Y); float* SSQ = (float*)(ws + WS_SSQ); \
    (void)xres; (void)wl; (void)XB; (void)HB; (void)YB; (void)SSQ
#define MINI_GU(Ain, Wgu, ssqs) do { const int half = F.G / 2; if (F.bid >= half) for (int mu = F.bid - half; mu < 4 * (FF / 16); mu += F.G - half) mini_gu(F, Ain, Wgu, ssqs, HB, mu); } while (0)
template <int l> __device__ __forceinline__ void layer_phases(const Frame& F, const int lo, const int hi) {
        const int pb = 1 + 8 * l;
        if (IN(pb + 0)) {
            WS_PTRS; pg8::Gemm g{YB, wl + OW_GU1, MPR, 2 * FF, D}; pg8::StaticOrder S; S.init(MPR, 2 * FF, F.G, F.bid); EpiGU E{HB, (const float*)(ws + WS_SSQ2)};
            stage_rs<6>(F, (const float*)(ws + WS_SSQ2), S);
            pg8::gemm_phase<EpiGU, pg8::StaticOrder, true, true>(F.lds, g, S, E, F.wave);
            MINI_GU(YB, wl + OW_GU1, (const float*)(ws + WS_SSQS_B)); }
        SEAM(pb + 0);
        if (IN(pb + 1)) {
            WS_PTRS; pg8::Gemm g{HB, wl + OW_D1, MPR, D, FF}; pg8::StaticOrder S; S.init(MPR, D, F.G, F.bid);
            EpiRes<0> E{YB, XB, SSQ, nullptr, nullptr, 0.5f};
            pg8::gemm_phase<EpiRes<0>, pg8::StaticOrder, true, true>(F.lds, g, S, E, F.wave);
            for (int mu = F.vcu; mu < 256; mu += F.G) mini_res<0>(F, HB, FF, wl + OW_D1, YB, XB, (float*)(ws + WS_SSQS_A), 0.5f, nullptr, nullptr, nullptr, mu); }
        SEAM(pb + 1);
        if (IN(pb + 2)) {
            WS_PTRS; pg8::Gemm g{XB, wl + OW_IN, MPR, INW, D}; pg8::StaticOrder S; S.init(MPR, INW, F.G, F.bid);
            EpiWin E{YB, (float*)(ws + WS_HZ), (float*)(ws + WS_HZ + (size_t)MP * WA * 4), (float*)(ws + WS_VST), SSQ};
            stage_rs<2>(F, SSQ, S);
            pg8::gemm_phase<EpiWin, pg8::StaticOrder, true, true>(F.lds, g, S, E, F.wave);
            for (int mu = F.vcu; mu < 512; mu += F.G) mini_win(F, XB, wl + OW_IN, (const float*)(ws + WS_SSQS_A), YB, (float*)(ws + WS_HZ), (float*)(ws + WS_HZ + (size_t)MP * WA * 4), (float*)(ws + WS_VSTS), mu); }
        SEAM(pb + 2);
        if (IN(pb + 3)) {
            {
                const int vcu = (F.G % 8 == 0) ? (F.bid % 8) * (F.G / 8) + F.bid / 8 : F.bid;
                for (int u = vcu; u < NB * 8 * 4; u += F.G) rglru_unit(F, l, u); }
            gmlp_units(F, l);
            for (int u = F.bid; u < MS; u += F.G) sample_mix_unit(F, l, u);
            LBAR(); }
        SEAM(pb + 3);
        if (IN(pb + 4)) {
            WS_PTRS; pg8::Gemm g{YB, wl + OW_OUT, MPR, D, D}; pg8::StaticOrder S; S.init(MPR, D, F.G, F.bid);
            EpiRes<0> E{XB, XB, SSQ, nullptr, nullptr, 1.0f};
            pg8::gemm_phase<EpiRes<0>, pg8::StaticOrder, true, true>(F.lds, g, S, E, F.wave);
            for (int mu = F.vcu; mu < 256; mu += F.G) mini_res<0>(F, YB, D, wl + OW_OUT, XB, XB, (float*)(ws + WS_SSQS_A), 1.0f, nullptr, nullptr, nullptr, mu); }
        SEAM(pb + 4);
        if (IN(pb + 5)) {
            WS_PTRS; pg8::Gemm g{XB, wl + OW_GU2, MPR, 2 * FF, D}; pg8::StaticOrder S; S.init(MPR, 2 * FF, F.G, F.bid); EpiGU E{HB, SSQ};
            stage_rs<6>(F, SSQ, S);
            pg8::gemm_phase<EpiGU, pg8::StaticOrder, true, true>(F.lds, g, S, E, F.wave);
            MINI_GU(XB, wl + OW_GU2, (const float*)(ws + WS_SSQS_A)); }
        SEAM(pb + 5);
        if (IN(pb + 6)) {
            WS_PTRS; pg8::Gemm g{HB, wl + OW_D2, MPR, D, FF}; pg8::StaticOrder S; S.init(MPR, D, F.G, F.bid);
            EpiRes<0> E{XB, XB, SSQ, nullptr, nullptr, 0.5f};
            pg8::gemm_phase<EpiRes<0>, pg8::StaticOrder, true, true>(F.lds, g, S, E, F.wave);
            for (int mu = F.vcu; mu < 256; mu += F.G) mini_res<0>(F, HB, FF, wl + OW_D2, XB, XB, (float*)(ws + WS_SSQS_A), 0.5f, nullptr, nullptr, nullptr, mu); }
        SEAM(pb + 6);
        if (IN(pb + 7)) {
            { WS_PTRS; pg8::Gemm g{(bf16_t*)(ws + WS_PB) + (size_t)l * MP * PLE, wl + OW_PP, MPR, D, PLE}; pg8::StaticOrder S; S.init(MPR, D, F.G, F.bid); EpiBf E{(bf16_t*)(ws + WS_HZ)};
              pg8::gemm_phase<EpiBf, pg8::StaticOrder, true, true>(F.lds, g, S, E, F.wave); }
            { WS_PTRS; pg8::Gemm g{XB, wl + OW_PG, MPR, D, D}; pg8::StaticOrder S; S.init(MPR, D, F.G, F.bid);
              EpiRes<1> E{XB, YB, (float*)(ws + WS_SSQ2), SSQ, (const bf16_t*)(ws + WS_HZ), 1.0f};
              stage_rs<1>(F, SSQ, S);
              pg8::gemm_phase<EpiRes<1>, pg8::StaticOrder, true, true>(F.lds, g, S, E, F.wave);
              for (int mu = F.vcu; mu < 256; mu += F.G) mini_res<1>(F, XB, D, wl + OW_PG, XB, YB, (float*)(ws + WS_SSQS_B), 1.0f, (const float*)(ws + WS_SSQS_A), (bf16_t*)(ws + WS_PB) + (size_t)l * MP * PLE, wl + OW_PP, mu); } }
        SEAM(pb + 7);
    }
#undef IN
#undef SEAM

__global__ void __launch_bounds__(NWAVES * 64, 2) fwd_kernel(Args a_unused) {
    extern __shared__ __attribute__((aligned(16))) unsigned char lds_raw[];
    Frame F;
    F.lds = (LAS unsigned char*)lds_raw;
    F.G = gridDim.x; F.bid = blockIdx.x; F.in = nullptr; F.wave = __builtin_amdgcn_readfirstlane((int)threadIdx.x >> 6);
    F.vcu = (F.G % 8 == 0) ? (F.bid % 8) * (F.G / 8) + F.bid / 8 : F.bid;
    int lo, hi; { const CArgs* ap = kargs(); lo = ap->ph_lo; hi = ap->ph_hi; }
    if (hi - lo > 1) {
        if (threadIdx.x < 2) ((volatile LAS unsigned*)(F.lds + 131072 + 64))[threadIdx.x] = 0u;
        __syncthreads();
        if (threadIdx.x == 0) (void)xb_add(&((unsigned*)(kargs()->ws))[XB_XCNT(xb_xcc_id())], 1u);
    }
#define IN(k) (lo <= (k) && (k) < hi)
#define SEAM(k) do { if (IN(k) && IN((k) + 1)) cg::this_grid().sync(); } while (0)
    if (IN(0)) { p0_prologue(F); }
    SEAM(0);
    layer_phases<0>(F, lo, hi);
    layer_phases<1>(F, lo, hi);
    if (IN(N_PHASES - 1)) {
        const CArgs* ap = kargs(); float* yout = ap->out; const float* SSQ = (const float*)(ap->ws + WS_SSQ2); const float* nf = ap->in[31]; const bf16_t* XF = (const bf16_t*)(ap->ws + WS_Y);
        LOCAL_IDS; const int gw = F.bid * NWAVES + w, NGW = F.G * NWAVES;
        if (gw < MV) {
            int m = gw; u32x2 xq[4]; f32x4 pa; f32x4 gn[4];
#pragma unroll
            for (int j = 0; j < 4; ++j) gn[j] = ((const f32x4*)nf)[lane + 64 * j];
#define F_LOAD(mm) do { pa = (mm) < MPR ? *(const f32x4*)(SSQ + (size_t)(mm) * 16 + (lane & 3) * 4) : *(const f32x4*)((const float*)(ap->ws + WS_SSQS_B) + ((mm) - MPR) * 64 + (lane & 15) * 4); \
            const u32x2* xr_ = (const u32x2*)(XF + (size_t)(mm) * D) + lane; _Pragma("unroll") for (int j = 0; j < 4; ++j) xq[j] = xr_[64 * j]; } while (0)
            f32x4 yv[4];
#define F_COMP(mm) do { float s_ = (pa.x + pa.y) + (pa.z + pa.w); s_ += __shfl_xor(s_, 1); s_ += __shfl_xor(s_, 2); \
            if ((mm) >= MPR) { s_ += __shfl_xor(s_, 4); s_ += __shfl_xor(s_, 8); } \
            const float rs_ = rsqrtf(s_ * (1.f / D) + EPS); \
            _Pragma("unroll") for (int j = 0; j < 4; ++j) yv[j] = unpk4(xq[j]) * rs_ * gn[j]; \
            asm volatile("" : "+v"(yv[0]), "+v"(yv[1]), "+v"(yv[2]), "+v"(yv[3])); } while (0)
            F_LOAD(m); F_COMP(m);
            bool has = m + NGW < MV; if (has) F_LOAD(m + NGW);
            for (;;) {
                f32x4* yo = (f32x4*)(yout + (size_t)m * D) + lane;
#pragma unroll
                for (int j = 0; j < 4; ++j) __builtin_nontemporal_store(yv[j], yo + 64 * j);
                if (!has) break;
                m += NGW; F_COMP(m);
                has = m + NGW < MV; if (has) F_LOAD(m + NGW);
            }
#undef F_COMP
#undef F_LOAD
        }
    }
#undef IN
#undef SEAM
#undef WS_PTRS
}

extern "C" void kernel_launch(void* const* d_in, const int* in_sizes, int n_in, void* d_out, int out_size, void* d_ws, size_t ws_size, hipStream_t stream) {
    static int grid = 0;
    if (grid == 0) {
        if (n_in != 32 || (size_t)out_size != OO_END || ws_size < WS_END) { fprintf(stderr, "kernel_launch: unexpected shapes (n_in %d, out %d, ws %zu, need %zu)\n", n_in, out_size, ws_size, (size_t)WS_END); grid = -1; return; }
        int dev = 0, cus = 0, per_cu = 0;
        if (hipGetDevice(&dev) != hipSuccess || hipDeviceGetAttribute(&cus, hipDeviceAttributeMultiprocessorCount, dev) != hipSuccess) { grid = -1; return; }
        if (hipFuncSetAttribute((const void*)fwd_kernel, hipFuncAttributeMaxDynamicSharedMemorySize, LDS_BYTES) != hipSuccess) { fprintf(stderr, "kernel_launch: hipFuncSetAttribute failed\n"); grid = -1; return; }
        if (hipOccupancyMaxActiveBlocksPerMultiprocessor(&per_cu, (const void*)fwd_kernel, NWAVES * 64, LDS_BYTES) != hipSuccess || per_cu < 1) { fprintf(stderr, "kernel_launch: occupancy query says %d\n", per_cu); per_cu = 1; }
        (void)hipGetLastError();
        grid = cus;
    }
    if (grid < 0) return;
    if (hipMemsetAsync(d_ws, 0, 16384, stream) != hipSuccess) { fprintf(stderr, "kernel_launch: memset failed\n"); return; }
    Args a{};
    for (int i = 0; i < 32; ++i) a.in[i] = (const float*)d_in[i];
    a.out = (float*)d_out; a.ws = (unsigned char*)d_ws;
#ifdef PROBE_LIST
    {
        const int plist[] = PROBE_LIST;
        for (unsigned i = 0; i < sizeof(plist) / sizeof(plist[0]); ++i) { a.ph_lo = plist[i]; a.ph_hi = plist[i] + 1; hipLaunchKernelGGL(fwd_kernel, dim3(grid), dim3(NWAVES * 64), LDS_BYTES, stream, a); }
    }
#endif
#if ONE_LAUNCH
    a.ph_lo = 0; a.ph_hi = N_PHASES;
    void* args[] = {&a};
    hipError_t e = hipLaunchCooperativeKernel((const void*)fwd_kernel, dim3(grid), dim3(NWAVES * 64), args, LDS_BYTES, stream);
    if (e != hipSuccess) fprintf(stderr, "cooperative launch failed: %s (grid %d)\n", hipGetErrorString(e), grid);
#else
    for (int p = 0; p < N_PHASES; ++p) {
        a.ph_lo = p; a.ph_hi = p + 1;
        hipLaunchKernelGGL(fwd_kernel, dim3(grid), dim3(NWAVES * 64), LDS_BYTES, stream, a);
    }
#endif
}
```
